# Optimizing an MI355X kernel written in HIP

```python
import math
import jax, jax.numpy as jnp
from jax import lax
import numpy as np

D_MODEL = 1024
BATCH = 2
SEQ = 8192
DEPTH = 1

GRID_W = 64
CTX_LEN = 256
HEAD_DIM = 64
N_Q_HEADS = 8
N_KV_HEADS = 2
GROUP = N_Q_HEADS // N_KV_HEADS
WINDOW = 128
BLOCK = 128
ROPE_THETA = 10000.0
N_FOURIER_GROUPS = 4
FOURIER_GROUP_CH = 128
FOURIER_W = N_FOURIER_GROUPS * FOURIER_GROUP_CH
Q_W = N_Q_HEADS * HEAD_DIM
KV_W = N_KV_HEADS * HEAD_DIM
IN_W = Q_W + 2 * KV_W + FOURIER_W + 2 * D_MODEL
D_FF = 2816
CONV_WIDTH = 3
EPS = 1e-6
NEG = -1e30

kernel_name = "hybrid_swa_fnet_convffn_dit_block"


def rmsnorm(x, g):
    xf = x.astype(jnp.float32)
    xf = xf * lax.rsqrt(jnp.mean(xf * xf, axis=-1, keepdims=True) + EPS)
    return xf.astype(x.dtype) * g


def modulate(h, shift, scale):
    return h * (1 + scale) + shift


def adaln(cvec, w_mod, b_mod):
    return jnp.split(jax.nn.silu(cvec) @ w_mod + b_mod, 6, axis=-1)


def axial_rope_tables(rows, dtype):
    row = jnp.repeat(jnp.arange(rows), GRID_W).astype(jnp.float32)
    col = jnp.tile(jnp.arange(GRID_W), rows).astype(jnp.float32)
    half = HEAD_DIM // 2
    inv_freq = ROPE_THETA ** (-jnp.arange(0, half, 2, dtype=jnp.float32) / half)
    ang_r = (row[:, None] * inv_freq)[:, None, :]
    ang_c = (col[:, None] * inv_freq)[:, None, :]
    return tuple(t.astype(dtype) for t in (jnp.cos(ang_r), jnp.sin(ang_r), jnp.cos(ang_c), jnp.sin(ang_c)))


def rotate(x, cos, sin):
    x1, x2 = jnp.split(x, 2, axis=-1)
    return jnp.concatenate([x1 * cos - x2 * sin, x2 * cos + x1 * sin], axis=-1)


def apply_axial_rope(x, tabs):
    cos_r, sin_r, cos_c, sin_c = tabs
    xr, xc = jnp.split(x, 2, axis=-1)
    return jnp.concatenate([rotate(xr, cos_r, sin_r), rotate(xc, cos_c, sin_c)], axis=-1)


def split_proj(p):
    o1 = Q_W
    o2 = o1 + KV_W
    o3 = o2 + KV_W
    o4 = o3 + FOURIER_W
    o5 = o4 + D_MODEL
    return p[..., :o1], p[..., o1:o2], p[..., o2:o3], p[..., o3:o4], p[..., o4:o5], p[..., o5:]


def banded_window_attention(q, k, v, k_ctx, v_ctx, sink):
    B, S = q.shape[:2]
    L = k_ctx.shape[1]
    nb = S // BLOCK
    scale = HEAD_DIM ** -0.5
    qb = q.reshape(B, nb, BLOCK, N_KV_HEADS, GROUP, HEAD_DIM)

    def band(t):
        tp = jnp.pad(t, ((0, 0), (BLOCK, BLOCK), (0, 0), (0, 0)))
        tp = tp.reshape(B, nb + 2, BLOCK, N_KV_HEADS, HEAD_DIM)
        return jnp.concatenate([tp[:, :-2], tp[:, 1:-1], tp[:, 2:]], axis=2)

    kw, vw = band(k), band(v)
    s_loc = jnp.einsum('bnqhgd,bnkhd->bnhgqk', qb, kw).astype(jnp.float32) * scale
    s_ctx = jnp.einsum('bnqhgd,blhd->bnhgql', qb, k_ctx).astype(jnp.float32) * scale
    qi = jnp.arange(BLOCK)[:, None]
    kj = jnp.arange(3 * BLOCK)[None, :]
    rel = kj - BLOCK - qi
    kpos = jnp.arange(nb)[:, None, None] * BLOCK + kj[None] - BLOCK
    valid = (jnp.abs(rel) <= WINDOW)[None] & (kpos >= 0) & (kpos < S)
    s_loc = jnp.where(valid[None, :, None, None], s_loc, NEG)
    sink_l = jnp.broadcast_to(sink.astype(jnp.float32).reshape(1, 1, N_KV_HEADS, GROUP, 1, 1),
                              s_loc.shape[:-1] + (1,))
    p = jax.nn.softmax(jnp.concatenate([s_loc, s_ctx, sink_l], axis=-1), axis=-1)
    p_loc = p[..., :3 * BLOCK].astype(v.dtype)
    p_ctx = p[..., 3 * BLOCK:3 * BLOCK + L].astype(v.dtype)
    o = (jnp.einsum('bnhgqk,bnkhd->bnqhgd', p_loc, vw)
         + jnp.einsum('bnhgql,blhd->bnqhgd', p_ctx, v_ctx))
    return o.reshape(B, S, Q_W)


def context_attention(q, k, v, sink):
    B, L = q.shape[:2]
    scale = HEAD_DIM ** -0.5
    qg = q.reshape(B, L, N_KV_HEADS, GROUP, HEAD_DIM)
    s = jnp.einsum('blhgd,bmhd->bhglm', qg, k).astype(jnp.float32) * scale
    sink_l = jnp.broadcast_to(sink.astype(jnp.float32).reshape(1, N_KV_HEADS, GROUP, 1, 1),
                              s.shape[:-1] + (1,))
    p = jax.nn.softmax(jnp.concatenate([s, sink_l], axis=-1), axis=-1)[..., :L].astype(v.dtype)
    o = jnp.einsum('bhglm,bmhd->blhgd', p, v)
    return o.reshape(B, L, Q_W)


def fourier_mix(f):
    B, S = f.shape[:2]
    fg = f.reshape(B, S, N_FOURIER_GROUPS, FOURIER_GROUP_CH).astype(jnp.float32)
    out = jnp.fft.fft2(fg, axes=(1, 3), norm='ortho').real
    return out.reshape(B, S, FOURIER_W).astype(f.dtype)


def merge_branches(attn_o, four_o, g_a, g_f, w_pa, w_pf, w_out):
    m = jax.nn.sigmoid(g_a) * (attn_o @ w_pa) + jax.nn.sigmoid(g_f) * (four_o @ w_pf)
    return m @ w_out


def conv_ffn(h, w_up, conv_w, conv_b, w_down):
    u, gate = jnp.split(h @ w_up, 2, axis=-1)
    up = jnp.pad(u, ((0, 0), (1, 1), (0, 0)))
    u = up[:, :-2] * conv_w[0] + up[:, 1:-1] * conv_w[1] + up[:, 2:] * conv_w[2] + conv_b
    return (jax.nn.silu(u) * gate) @ w_down


def setup_inputs(seed: int = 0) -> dict:
    key = jax.random.key(seed)
    ks = jax.random.split(key, 19)
    f32 = jnp.float32
    D = D_MODEL

    def nrm(k, shape, s):
        return jax.random.normal(k, shape, f32) * s

    return {
        'x': nrm(ks[0], (BATCH, SEQ, D), 1.0),
        'c': nrm(ks[1], (BATCH, D), 1.0),
        'ctx': nrm(ks[2], (BATCH, CTX_LEN, D), 1.0),
        'c_ctx': nrm(ks[3], (D,), 1.0),
        'w_mod': nrm(ks[4], (DEPTH, D, 6 * D), 0.5 * D ** -0.5),
        'b_mod': nrm(ks[5], (DEPTH, 6 * D), 0.01),
        'g_pre1': 1.0 + nrm(ks[6], (DEPTH, D), 0.05),
        'g_post1': 1.0 + nrm(ks[7], (DEPTH, D), 0.05),
        'g_pre2': 1.0 + nrm(ks[8], (DEPTH, D), 0.05),
        'g_post2': 1.0 + nrm(ks[9], (DEPTH, D), 0.05),
        'w_in': nrm(ks[10], (DEPTH, D, IN_W), D ** -0.5),
        'sink': nrm(ks[11], (DEPTH, N_Q_HEADS), 0.5),
        'w_pa': nrm(ks[12], (DEPTH, Q_W, D), Q_W ** -0.5),
        'w_pf': nrm(ks[13], (DEPTH, FOURIER_W, D), FOURIER_W ** -0.5),
        'w_out': nrm(ks[14], (DEPTH, D, D), D ** -0.5),
        'w_up': nrm(ks[15], (DEPTH, D, 2 * D_FF), D ** -0.5),
        'conv_w': nrm(ks[16], (DEPTH, CONV_WIDTH, D_FF), CONV_WIDTH ** -0.5),
        'conv_b': nrm(ks[17], (DEPTH, D_FF), 0.01),
        'w_down': nrm(ks[18], (DEPTH, D_FF, D), D_FF ** -0.5),
    }


def reference(x, c, ctx, c_ctx, w_mod, b_mod, g_pre1, g_post1, g_pre2, g_post2,
              w_in, sink, w_pa, w_pf, w_out, w_up, conv_w, conv_b, w_down):
    B, S, _ = x.shape
    L = ctx.shape[1]
    ROWS = S // GRID_W
    tabs = axial_rope_tables(ROWS, x.dtype)
    for l in range(DEPTH):
        last = l == DEPTH - 1
        sh1, sc1, gt1, sh2, sc2, gt2 = [m[:, None] for m in adaln(c, w_mod[l], b_mod[l])]
        csh1, csc1, cgt1, csh2, csc2, cgt2 = adaln(c_ctx, w_mod[l], b_mod[l])

        h = modulate(rmsnorm(x, g_pre1[l]), sh1, sc1)
        hc = modulate(rmsnorm(ctx, g_pre1[l]), csh1, csc1)
        q, k, v, f, g_a, g_f = split_proj(h @ w_in[l])
        q = apply_axial_rope(q.reshape(B, S, N_Q_HEADS, HEAD_DIM), tabs)
        k = apply_axial_rope(k.reshape(B, S, N_KV_HEADS, HEAD_DIM), tabs)
        v = v.reshape(B, S, N_KV_HEADS, HEAD_DIM)
        if last:
            pc = hc @ w_in[l, :, :Q_W + 2 * KV_W]
        else:
            pc = hc @ w_in[l]
        kc = pc[..., Q_W:Q_W + KV_W].reshape(B, L, N_KV_HEADS, HEAD_DIM)
        vc = pc[..., Q_W + KV_W:Q_W + 2 * KV_W].reshape(B, L, N_KV_HEADS, HEAD_DIM)

        attn = banded_window_attention(q, k, v, kc, vc, sink[l])
        y = merge_branches(attn, fourier_mix(f), g_a, g_f, w_pa[l], w_pf[l], w_out[l])
        x = x + gt1 * rmsnorm(y, g_post1[l])

        if not last:
            qc, _, _, fc, g_ac, g_fc = split_proj(pc)
            attn_c = context_attention(qc.reshape(B, L, N_Q_HEADS, HEAD_DIM), kc, vc, sink[l])
            yc = merge_branches(attn_c, fourier_mix(fc), g_ac, g_fc, w_pa[l], w_pf[l], w_out[l])
            ctx = ctx + cgt1 * rmsnorm(yc, g_post1[l])

        h2 = modulate(rmsnorm(x, g_pre2[l]), sh2, sc2)
        x = x + gt2 * rmsnorm(conv_ffn(h2, w_up[l], conv_w[l], conv_b[l], w_down[l]), g_post2[l])

        if not last:
            hc2 = modulate(rmsnorm(ctx, g_pre2[l]), csh2, csc2)
            ctx = ctx + cgt2 * rmsnorm(conv_ffn(hc2, w_up[l], conv_w[l], conv_b[l], w_down[l]), g_post2[l])
    return x
```

```cpp
#include <cstddef>
constexpr size_t MiB = 1u << 20;
constexpr size_t WS_CTL = 0, CTL_ZERO_BYTES = 1 * MiB;
constexpr size_t WS_WIN = 1 * MiB, WS_WUP = 8 * MiB, WS_WDN = 19 * MiB, WS_WCAT = 25 * MiB, WS_WOUT = 28 * MiB, WS_TAB = 30 * MiB;
constexpr size_t WS_H = 31 * MiB;
constexpr size_t WS_Q = 65 * MiB, WS_K = 81 * MiB, WS_V = 86 * MiB, WS_F = 91 * MiB, WS_Y1 = 107 * MiB, WS_ACAT = 139 * MiB, WS_GA = 187 * MiB, WS_GF = 219 * MiB;
constexpr size_t WS_MB = 65 * MiB;
constexpr size_t WS_YB = 107 * MiB;
constexpr size_t WS_U = 65 * MiB, WS_G = 153 * MiB;
constexpr size_t WS_ZB = 65 * MiB;
constexpr size_t WS_END = 251 * MiB;
constexpr int CW_BAR = 4096;
constexpr int CW_MOD = 32768;
constexpr int TA_ELEMS = 128 * 64, TB_ELEMS = 256 * 256;
#include <hip/hip_runtime.h>
#include <cstdio>
#include <cstdint>
namespace pg8 {
#define PG8_LAS __attribute__((address_space(3)))
typedef unsigned short bf16_t;
typedef short bf16x8 __attribute__((ext_vector_type(8)));
typedef float f32x4 __attribute__((ext_vector_type(4)));
typedef unsigned u32x4 __attribute__((ext_vector_type(4)));
constexpr int BM = 256, BK = 64, HALF = 128, HTB = HALF * BK * 2  , STAGE_BYTES = 8 * HTB, NXCD = 8, WGM = 8;

__host__ __device__ __forceinline__ int lds_byte(int r, int c) { const int st = (r >> 4) * 2 + (c >> 5), rr = r & 15, cc = c & 31, ob = rr * 64 + cc * 2; return st * 1024 + (ob ^ (((ob >> 9) & 1) << 5)); }
__host__ __device__ __forceinline__ void stage_rc(int b, int& R, int& C) { const int st = b / 1024, sb = b % 1024, swz = sb ^ (((sb >> 9) & 1) << 5); R = (st >> 1) * 16 + swz / 64; C = (st & 1) * 32 + (swz % 64) / 2; }
__host__ __device__ __forceinline__ int perm32(int rho) { const int n = rho >> 4, i = rho & 15; return 8 * (i >> 2) + 4 * n + (i & 3); }

struct Unit { int pm, pn; };
struct Gemm { const bf16_t* A; const bf16_t* Bt; int M, N, K; };

struct StaticOrder {
    int nM, nN, nwg, G, c;
    __host__ __device__ void init(int M, int N, int G_, int c_) { nM = M / BM; nN = N / BM; nwg = nM * nN; G = G_; c = c_; }
    __host__ __device__ bool next(int i, Unit& u) const {
        const long L = (long)i * G + c; if (L >= nwg) return false;
        int wgid = (int)L; { const int q = nwg / NXCD, r = nwg % NXCD, xcd = wgid % NXCD, off = wgid / NXCD; wgid = (xcd < r ? xcd * (q + 1) : r * (q + 1) + (xcd - r) * q) + off; }
        const int nig = WGM * nN, gid = wgid / nig, fm = gid * WGM, gsz = (nM - fm) < WGM ? (nM - fm) : WGM;
        u.pm = fm + ((wgid % nig) % gsz); u.pn = (wgid % nig) / gsz; return true;
    }
    __device__ __forceinline__ void a_ready(const Unit&) const {}
    __device__ __forceinline__ void done(const Unit&) const {}
};

__device__ __forceinline__ unsigned cvt_pk_bf16(float lo, float hi) { unsigned r; asm volatile("v_cvt_pk_bf16_f32 %0, %1, %2" : "=v"(r) : "v"(lo), "v"(hi)); return r; }
typedef float f32x2 __attribute__((ext_vector_type(2)));
typedef unsigned u32x2 __attribute__((ext_vector_type(2)));
__device__ __forceinline__ float bf_lo(unsigned w) { return __uint_as_float(w << 16); }
__device__ __forceinline__ float bf_hi(unsigned w) { return __uint_as_float(w & 0xffff0000u); }
__device__ __forceinline__ float sigmoid_f(float x) { return __builtin_amdgcn_rcpf(1.0f + __expf(-x)); }

struct EpiBf16 {
    static constexpr bool PERM = true, AFTER_DRAIN = false; static constexpr int MID_T = 0;
    bf16_t* O; int ldc; int split_cols; size_t split_stride;
    __device__ __forceinline__ void operator()(const f32x4 (&acc)[2][2][4][2], const Unit& u, int wr, int wc, int fr, int fq) const {
        const int row0 = u.pm * BM + wr * 64 + fr; int colt = u.pn * BM; bf16_t* base = O;
        if (split_cols) { const int t = colt / split_cols; base += (size_t)t * split_stride; colt -= t * split_cols; }
        const int col0 = colt + wc * 32 + 8 * fq;
#pragma unroll
        for (int ai = 0; ai < 2; ++ai)
#pragma unroll
            for (int m = 0; m < 4; ++m) { bf16_t* rowp = base + (size_t)(row0 + ai * HALF + m * 16) * ldc + col0;
#pragma unroll
                for (int bj = 0; bj < 2; ++bj) { const f32x4 v0 = acc[ai][bj][m][0], v1 = acc[ai][bj][m][1];
                    u32x4 w; w.x = cvt_pk_bf16(v0[0], v0[1]); w.y = cvt_pk_bf16(v0[2], v0[3]); w.z = cvt_pk_bf16(v1[0], v1[1]); w.w = cvt_pk_bf16(v1[2], v1[3]);
                    *(u32x4*)(rowp + bj * HALF) = w; } }
    }
};

struct EpiIn {
    static constexpr bool PERM = false, AFTER_DRAIN = false; static constexpr int MID_T = 0;
    bf16_t* base0; float qscale;
    static constexpr unsigned oQ = WS_Q / 2, oK = WS_K / 2, oV = WS_V / 2, oF = WS_F / 2, oGA = WS_GA / 2, oGF = WS_GF / 2;
    __device__ __forceinline__ void operator()(const f32x4 (&acc)[2][2][4][2], const Unit& u, int wr, int wc, int fr, int fq) const {
        const int pn = u.pn;
        const int row0 = u.pm * BM + wr * 64 + fr;
        if (pn <= 2) {
            float invf[4];
#pragma unroll
            for (int j = 0; j < 4; ++j) invf[j] = exp2f(-(float)(4 * fq + j) * 0.830482023f) * 0.15915494309f;
#pragma unroll
            for (int ai = 0; ai < 2; ++ai)
#pragma unroll
                for (int m = 0; m < 4; ++m) {
                    const int row = row0 + ai * HALF + m * 16;
                    const int t = row & 8191; const float pos = (float)((wc & 1) ? (t & 63) : (t >> 6));
                    float cs[4], sn[4];
#pragma unroll
                    for (int j = 0; j < 4; ++j) { const float rev = pos * invf[j]; const float fr_ = rev - floorf(rev); cs[j] = __builtin_amdgcn_cosf(fr_); sn[j] = __builtin_amdgcn_sinf(fr_); }
#pragma unroll
                    for (int bj = 0; bj < 2; ++bj) {
                        f32x4 v0 = acc[ai][bj][m][0], v1 = acc[ai][bj][m][1];
                        const bool rope = (pn < 2) || (bj == 0 && row < 16384);
                        if (rope) {
#pragma unroll
                            for (int j = 0; j < 4; ++j) { const float a = v0[j], b = v1[j]; v0[j] = a * cs[j] - b * sn[j]; v1[j] = b * cs[j] + a * sn[j]; }
                        }
                        unsigned doff;
                        if (pn < 2) { v0 = v0 * qscale; v1 = v1 * qscale; doff = oQ + (unsigned)row * 512u + pn * 256 + bj * HALF + wc * 32 + 4 * fq; }
                        else doff = (bj == 0 ? oK : oV) + (unsigned)row * 128u + wc * 32 + 4 * fq;
                        bf16_t* dst = base0 + doff;
                        u32x2 w0, w1; w0.x = cvt_pk_bf16(v0[0], v0[1]); w0.y = cvt_pk_bf16(v0[2], v0[3]); w1.x = cvt_pk_bf16(v1[0], v1[1]); w1.y = cvt_pk_bf16(v1[2], v1[3]);
                        *(u32x2*)dst = w0; *(u32x2*)(dst + 16) = w1;
                    }
                }
        } else {
            const bool isf = pn <= 4;
            unsigned boff; int ldc, colt;
            if (isf) { boff = oF; ldc = 512; colt = (pn - 3) * 256; }
            else if (pn <= 8) { boff = oGA; ldc = 1024; colt = (pn - 5) * 256; }
            else { boff = oGF; ldc = 1024; colt = (pn - 9) * 256; }
            bf16_t* base = base0 + boff;
#pragma unroll
            for (int ai = 0; ai < 2; ++ai)
#pragma unroll
                for (int m = 0; m < 4; ++m) {
                    bf16_t* rowp = base + (size_t)(row0 + ai * HALF + m * 16) * ldc + colt + wc * 32 + 4 * fq;
#pragma unroll
                    for (int bj = 0; bj < 2; ++bj)
#pragma unroll
                        for (int n = 0; n < 2; ++n) {
                            f32x4 v = acc[ai][bj][m][n];
                            if (!isf) { v[0] = sigmoid_f(v[0]); v[1] = sigmoid_f(v[1]); v[2] = sigmoid_f(v[2]); v[3] = sigmoid_f(v[3]); }
                            u32x2 w; w.x = cvt_pk_bf16(v[0], v[1]); w.y = cvt_pk_bf16(v[2], v[3]);
                            *(u32x2*)(rowp + bj * HALF + n * 16) = w;
                        }
                }
        }
    }
};

struct EpiMerge {
    static constexpr bool PERM = true, AFTER_DRAIN = false; static constexpr int MID_T = 8;
    const bf16_t *GA, *GF; bf16_t* O;
    __device__ __forceinline__ void mid(f32x4 (&acc)[2][2][4][2], const Unit& u, int wr, int wc, int fr, int fq) const {
        const unsigned loff = (unsigned)(wr * 64 + fr) * 1024u + wc * 32 + 8 * fq;
        const size_t uoff = (size_t)(__builtin_amdgcn_readfirstlane(u.pm) * BM) * 1024 + __builtin_amdgcn_readfirstlane(u.pn) * BM;
#pragma unroll
        for (int ai = 0; ai < 2; ++ai)
#pragma unroll
            for (int m = 0; m < 4; ++m) { const bf16_t* pa = GA + uoff + (size_t)(ai * HALF + m * 16) * 1024; const bf16_t* pf = GF + uoff + (size_t)(ai * HALF + m * 16) * 1024;
#pragma unroll
                for (int bj = 0; bj < 2; ++bj) {
                    const u32x4 a = *(const u32x4*)(pa + bj * HALF + loff), f = *(const u32x4*)(pf + bj * HALF + loff);
                    f32x4 r0, r1;
                    r0[0] = bf_lo(a.x) * __builtin_amdgcn_rcpf(bf_lo(f.x)); r0[1] = bf_hi(a.x) * __builtin_amdgcn_rcpf(bf_hi(f.x));
                    r0[2] = bf_lo(a.y) * __builtin_amdgcn_rcpf(bf_lo(f.y)); r0[3] = bf_hi(a.y) * __builtin_amdgcn_rcpf(bf_hi(f.y));
                    r1[0] = bf_lo(a.z) * __builtin_amdgcn_rcpf(bf_lo(f.z)); r1[1] = bf_hi(a.z) * __builtin_amdgcn_rcpf(bf_hi(f.z));
                    r1[2] = bf_lo(a.w) * __builtin_amdgcn_rcpf(bf_lo(f.w)); r1[3] = bf_hi(a.w) * __builtin_amdgcn_rcpf(bf_hi(f.w));
                    acc[ai][bj][m][0] = acc[ai][bj][m][0] * r0; acc[ai][bj][m][1] = acc[ai][bj][m][1] * r1;
                }
                asm volatile("" : "+v"(acc[ai][0][m][0]), "+v"(acc[ai][0][m][1]), "+v"(acc[ai][1][m][0]), "+v"(acc[ai][1][m][1]));
                asm volatile("" ::: "memory"); }
    }
    __device__ __forceinline__ void operator()(const f32x4 (&acc)[2][2][4][2], const Unit& u, int wr, int wc, int fr, int fq) const {
        const unsigned loff = (unsigned)(wr * 64 + fr) * 1024u + wc * 32 + 8 * fq;
        const size_t uoff = (size_t)(__builtin_amdgcn_readfirstlane(u.pm) * BM) * 1024 + __builtin_amdgcn_readfirstlane(u.pn) * BM;
#pragma unroll
        for (int ai = 0; ai < 2; ++ai)
#pragma unroll
            for (int m = 0; m < 4; ++m) { const bf16_t* pf = GF + uoff + (size_t)(ai * HALF + m * 16) * 1024; bf16_t* po = O + uoff + (size_t)(ai * HALF + m * 16) * 1024;
#pragma unroll
                for (int bj = 0; bj < 2; ++bj) {
                    const u32x4 f = *(const u32x4*)(pf + bj * HALF + loff);
                    const f32x4 v0 = acc[ai][bj][m][0], v1 = acc[ai][bj][m][1];
                    u32x4 w;
                    w.x = cvt_pk_bf16(v0[0] * bf_lo(f.x), v0[1] * bf_hi(f.x)); w.y = cvt_pk_bf16(v0[2] * bf_lo(f.y), v0[3] * bf_hi(f.y));
                    w.z = cvt_pk_bf16(v1[0] * bf_lo(f.z), v1[1] * bf_hi(f.z)); w.w = cvt_pk_bf16(v1[2] * bf_lo(f.w), v1[3] * bf_hi(f.w));
                    *(u32x4*)(po + bj * HALF + loff) = w;
                }
                asm volatile("" ::: "memory"); }
    }
};

struct OrderIn {
    StaticOrder so; int G, c;
    __device__ void init(int G_, int c_) { so.init(16384, 3328, G_, c_); G = G_; c = c_; }
    __device__ bool next(int i, Unit& u) const {
        const long L = (long)i * G + c;
        if (L < so.nwg) return so.next(i, u);
        if (L < so.nwg + 2) { u.pm = 64 + (int)(L - so.nwg); u.pn = 2; return true; }
        return false;
    }
    __device__ __forceinline__ void a_ready(const Unit&) const {}
    __device__ __forceinline__ void done(const Unit&) const {}
};
template <class Epi, class Sched, bool ALIGN_EPI = false, bool SP2 = false>
__device__ __forceinline__ void gemm_phase(PG8_LAS unsigned char* lds, const Gemm g, const Sched& S, const Epi& E) {
    int tid_ = threadIdx.x; asm volatile("" : "+v"(tid_));
    const int tid = tid_, wid = __builtin_amdgcn_readfirstlane(tid >> 6), lane = tid & 63, wr = wid >> 2, wc = wid & 3, fr = lane & 15, fq = lane >> 4;
    const int K = g.K, nt = K / BK;
    unsigned voffA[2], voffB[2];
#pragma unroll
    for (int i = 0; i < 2; ++i) { int R, C; stage_rc(tid * 16 + i * 8192, R, C); const int Rb = Epi::PERM ? ((R & ~31) + perm32(R & 31)) : R;
        voffA[i] = (unsigned)(R * K + C) * 2u; voffB[i] = (unsigned)(Rb * K + C) * 2u; }
    const size_t kstep = (size_t)(BK * 2);
    const size_t hstep = (size_t)HALF * K * 2;
    const size_t tstep = 2 * hstep;
    const unsigned ldsw = (unsigned)wid * 1024u;
    const int aoff = lds_byte(wr * 64 + fr, fq * 8), boff = lds_byte(wc * 32 + fr, fq * 8);
#define PG8_SA(b, h) (((b) * 2 + (h)) * HTB)
#define PG8_SB(b, h) ((4 + (b) * 2 + (h)) * HTB)
#define PG8_STAGE(bufoff, gbase, voff) do { _Pragma("unroll") for (int _i = 0; _i < 2; ++_i) \
        __builtin_amdgcn_global_load_lds((const unsigned*)((const char*)(gbase) + (voff)[_i]), (PG8_LAS unsigned*)(lds + (bufoff) + ldsw + _i * 8192), 16, 0, 0); } while (0)
#define PG8_LDA(dst, b, h) do { _Pragma("unroll") for (int m = 0; m < 4; ++m) _Pragma("unroll") for (int k = 0; k < 2; ++k) dst[m][k] = *(const PG8_LAS bf16x8*)(lds + PG8_SA(b, h) + aoff + m * 2048 + k * 1024); } while (0)
#define PG8_LDB(dst, b, h) do { _Pragma("unroll") for (int n = 0; n < 2; ++n) _Pragma("unroll") for (int k = 0; k < 2; ++k) dst[n][k] = *(const PG8_LAS bf16x8*)(lds + PG8_SB(b, h) + boff + n * 2048 + k * 1024); } while (0)
#define PG8_MMA(ai, bj, At, Bt) do { __builtin_amdgcn_s_setprio(1); _Pragma("unroll") for (int m = 0; m < 4; ++m) _Pragma("unroll") for (int n = 0; n < 2; ++n) _Pragma("unroll") for (int k = 0; k < 2; ++k) \
        acc[ai][bj][m][n] = __builtin_amdgcn_mfma_f32_16x16x32_bf16(Bt[n][k], At[m][k], acc[ai][bj][m][n], 0, 0, 0); __builtin_amdgcn_s_setprio(0); } while (0)
#define PG8_WAIT_V(n) asm volatile("s_waitcnt vmcnt(" #n ")" ::: "memory")
#define PG8_WAIT_L(n) asm volatile("s_waitcnt lgkmcnt(" #n ")" ::: "memory")
#define PG8_BAR __builtin_amdgcn_s_barrier()
#define PG8_SCHED __builtin_amdgcn_sched_barrier(0)
    Unit cur, nxt; int ui = 0;
    if (!S.next(0, cur)) return;
    f32x4 acc[2][2][4][2];
#pragma unroll
    for (int a = 0; a < 2; ++a)
#pragma unroll
        for (int b = 0; b < 2; ++b)
#pragma unroll
            for (int m = 0; m < 4; ++m)
#pragma unroll
                for (int n = 0; n < 2; ++n) acc[a][b][m][n] = (f32x4){0.f, 0.f, 0.f, 0.f};
    bf16x8 At[4][2], B0[2][2], B1[2][2];
    const char* cA = (const char*)g.A + (size_t)cur.pm * tstep; const char* cB = (const char*)g.Bt + (size_t)cur.pn * tstep;
    S.a_ready(cur);
    if constexpr (SP2) {
        PG8_STAGE(PG8_SB(0, 0), cB, voffB); PG8_STAGE(PG8_SB(0, 1), cB + hstep, voffB); PG8_STAGE(PG8_SA(0, 0), cA, voffA); PG8_STAGE(PG8_SA(0, 1), cA + hstep, voffA);
        if (wr == 1) PG8_BAR;
        PG8_WAIT_V(2); PG8_BAR;
        PG8_STAGE(PG8_SB(1, 0), cB + kstep, voffB); PG8_STAGE(PG8_SA(1, 0), cA + kstep, voffA); PG8_STAGE(PG8_SB(1, 1), cB + hstep + kstep, voffB);
        PG8_WAIT_V(6); PG8_BAR;
    } else {
        PG8_STAGE(PG8_SB(0, 0), cB, voffB); PG8_STAGE(PG8_SA(0, 0), cA, voffA); PG8_STAGE(PG8_SB(0, 1), cB + hstep, voffB); PG8_STAGE(PG8_SA(0, 1), cA + hstep, voffA);
        if (wr == 1) PG8_BAR;
        PG8_WAIT_V(4); PG8_BAR;
        PG8_STAGE(PG8_SB(1, 0), cB + kstep, voffB); PG8_STAGE(PG8_SA(1, 0), cA + kstep, voffA); PG8_STAGE(PG8_SB(1, 1), cB + hstep + kstep, voffB);
        PG8_WAIT_V(6); PG8_BAR;
    }
    for (;;) {
        const bool has_next = S.next(ui + 1, nxt);
        const char* nA = has_next ? (const char*)g.A + (size_t)nxt.pm * tstep : cA; const char* nB = has_next ? (const char*)g.Bt + (size_t)nxt.pn * tstep : cB;
        for (int t = 0; t < nt; t += 2) {
            if constexpr (Epi::MID_T > 0) { if (t == Epi::MID_T) E.mid(acc, cur, wr, wc, fr, fq); }
            const bool last = (t == nt - 2);
            const char* a1 = cA + (size_t)(t + 1) * kstep;
            const char* a2 = last ? nA : cA + (size_t)(t + 2) * kstep; const char* b2 = last ? nB : cB + (size_t)(t + 2) * kstep;
            const char* a3 = a2 + kstep; const char* b3 = b2 + kstep;
            if (last && has_next) S.a_ready(nxt);
            if constexpr (SP2) {
            PG8_LDB(B0, 0, 0); PG8_LDB(B1, 0, 1); PG8_SCHED; PG8_LDA(At, 0, 0); PG8_STAGE(PG8_SA(1, 1), a1 + hstep, voffA);
            PG8_WAIT_V(8); PG8_WAIT_L(0); PG8_BAR; PG8_MMA(0, 0, At, B0); PG8_MMA(0, 1, At, B1); PG8_BAR; PG8_SCHED;
            PG8_LDA(At, 0, 1); PG8_STAGE(PG8_SB(0, 0), b2, voffB); PG8_STAGE(PG8_SB(0, 1), b2 + hstep, voffB); PG8_STAGE(PG8_SA(0, 0), a2, voffA);
            PG8_WAIT_V(8); PG8_WAIT_L(0); PG8_BAR; PG8_MMA(1, 0, At, B0); PG8_MMA(1, 1, At, B1); PG8_BAR; PG8_SCHED;
            PG8_LDB(B0, 1, 0); PG8_LDB(B1, 1, 1); PG8_SCHED; PG8_LDA(At, 1, 0); PG8_STAGE(PG8_SA(0, 1), a2 + hstep, voffA);
            PG8_WAIT_V(8); PG8_WAIT_L(0); PG8_BAR; PG8_MMA(0, 0, At, B0); PG8_MMA(0, 1, At, B1); PG8_BAR; PG8_SCHED;
            PG8_LDA(At, 1, 1); PG8_STAGE(PG8_SB(1, 0), b3, voffB); PG8_STAGE(PG8_SB(1, 1), b3 + hstep, voffB); PG8_STAGE(PG8_SA(1, 0), a3, voffA);
            PG8_WAIT_V(8); PG8_WAIT_L(0); PG8_BAR; PG8_MMA(1, 0, At, B0); PG8_MMA(1, 1, At, B1); PG8_BAR; PG8_SCHED;
            } else {
            PG8_LDB(B0, 0, 0); PG8_SCHED; PG8_LDA(At, 0, 0); PG8_STAGE(PG8_SA(1, 1), a1 + hstep, voffA);
            PG8_WAIT_L(8); PG8_BAR; PG8_WAIT_L(0); PG8_MMA(0, 0, At, B0); PG8_BAR; PG8_SCHED;
            PG8_LDB(B1, 0, 1); PG8_STAGE(PG8_SB(0, 0), b2, voffB);
            PG8_BAR; PG8_WAIT_L(0); PG8_MMA(0, 1, At, B1); PG8_BAR;
            PG8_LDA(At, 0, 1); PG8_STAGE(PG8_SA(0, 0), a2, voffA);
            PG8_BAR; PG8_WAIT_L(0); PG8_MMA(1, 0, At, B0); PG8_BAR; PG8_SCHED;
            PG8_STAGE(PG8_SB(0, 1), b2 + hstep, voffB);
            PG8_WAIT_V(6); PG8_BAR; PG8_MMA(1, 1, At, B1); PG8_BAR;
            PG8_LDB(B0, 1, 0); PG8_SCHED; PG8_LDA(At, 1, 0); PG8_STAGE(PG8_SA(0, 1), a2 + hstep, voffA);
            PG8_WAIT_L(8); PG8_BAR; PG8_WAIT_L(0); PG8_MMA(0, 0, At, B0); PG8_BAR; PG8_SCHED;
            PG8_LDB(B1, 1, 1); PG8_STAGE(PG8_SB(1, 0), b3, voffB);
            PG8_BAR; PG8_WAIT_L(0); PG8_MMA(0, 1, At, B1); PG8_BAR;
            PG8_LDA(At, 1, 1); PG8_STAGE(PG8_SA(1, 0), a3, voffA);
            PG8_BAR; PG8_WAIT_L(0); PG8_MMA(1, 0, At, B0); PG8_BAR; PG8_SCHED;
            PG8_STAGE(PG8_SB(1, 1), b3 + hstep, voffB);
            PG8_WAIT_V(6); PG8_BAR; PG8_MMA(1, 1, At, B1); PG8_BAR;
            }
        }
        if constexpr (ALIGN_EPI) { if (wr == 0) PG8_BAR; }
        if constexpr (!Epi::AFTER_DRAIN) { E(acc, cur, wr, wc, fr, fq); S.done(cur); }
        if (!has_next) break;
#pragma unroll
        for (int a = 0; a < 2; ++a)
#pragma unroll
            for (int b = 0; b < 2; ++b)
#pragma unroll
                for (int m = 0; m < 4; ++m)
#pragma unroll
                    for (int n = 0; n < 2; ++n) acc[a][b][m][n] = (f32x4){0.f, 0.f, 0.f, 0.f};
        cur = nxt; cA = nA; cB = nB; ++ui;
        if constexpr (ALIGN_EPI) { if (wr == 1) PG8_BAR; }
    }
    PG8_WAIT_V(0);
    if constexpr (!ALIGN_EPI) { if (wr == 0) PG8_BAR; }
    PG8_BAR;
    if constexpr (Epi::AFTER_DRAIN) { E.fused(acc, cur, wr, wc, fr, fq, lds, wid, lane); S.done(cur); }
#undef PG8_SA
#undef PG8_SB
#undef PG8_STAGE
#undef PG8_LDA
#undef PG8_LDB
#undef PG8_MMA
#undef PG8_WAIT_V
#undef PG8_WAIT_L
#undef PG8_BAR
#undef PG8_SCHED
}
}
#include <cmath>
#define GAS __attribute__((address_space(1)))
#define LAS __attribute__((address_space(3)))
typedef unsigned short bf16;
typedef unsigned v4u __attribute__((ext_vector_type(4)));
typedef float f32x4 __attribute__((ext_vector_type(4)));
typedef short bf16x8 __attribute__((ext_vector_type(8)));
typedef GAS unsigned gu32;
typedef GAS unsigned long long gu64;
#define RLX_AGENT __ATOMIC_RELAXED, __HIP_MEMORY_SCOPE_AGENT
#define LDS_WAIT() asm volatile("s_waitcnt lgkmcnt(0)" ::: "memory")
#define VM_WAIT() asm volatile("s_waitcnt vmcnt(0)" ::: "memory")
__device__ __forceinline__ unsigned long long rt() { return __builtin_amdgcn_s_memrealtime(); }
__device__ __forceinline__ unsigned f2bf(float f) { unsigned u = __builtin_bit_cast(unsigned, f); return (u + 0x7fffu + ((u >> 16) & 1u)) >> 16; }
__device__ __forceinline__ unsigned pk2(float lo, float hi) { return f2bf(lo) | (f2bf(hi) << 16); }

#define XB_TMO      128
#define XB_XCNT(j)  (256  + 64 * (j))
#define XB_XSUB(j)  (1280 + 64 * (j))
#define XB_XGEN(j)  (2304 + 64 * (j))
#define XB_TOP      3328
#define XB_TOPGEN   3392
#define XCD_BAR_WORDS 3456
#define XB_SPIN_CAP (1u << 18)

__device__ __forceinline__ unsigned xb_ld(unsigned* p)              { return __hip_atomic_load(p, __ATOMIC_RELAXED, __HIP_MEMORY_SCOPE_AGENT); }
__device__ __forceinline__ unsigned xb_add(unsigned* p, unsigned v) { return __hip_atomic_fetch_add(p, v, __ATOMIC_RELAXED, __HIP_MEMORY_SCOPE_AGENT); }
__device__ __forceinline__ unsigned xb_xcc_id() { return (unsigned)__builtin_amdgcn_s_getreg((3 << 11) | 20) & 0xFu; }
#define XB_SPIN(cond, bar) do { unsigned _sp = 0; while (cond) { __builtin_amdgcn_s_sleep(1); \
    if ((++_sp & 255u) == 0u) { if (xb_ld(&(bar)[XB_TMO])) break; if (_sp > XB_SPIN_CAP) { atomicAdd(&(bar)[XB_TMO], 1u); break; } } } } while (0)

struct XcdBarrier {
    unsigned* bar; unsigned x;
    volatile LAS unsigned* st;
};

__device__ __forceinline__ XcdBarrier xcd_barrier_post(unsigned* bar, volatile LAS unsigned* st) {
    XcdBarrier b; b.bar = bar; b.x = xb_xcc_id(); b.st = st;
    if (threadIdx.x == 0) (void)xb_add(&bar[XB_XCNT(b.x)], 1u);
    return b;
}
__device__ __forceinline__ void xcd_barrier_complete(unsigned* bar, unsigned x, unsigned& nloc, unsigned& nx) {
    const unsigned G = gridDim.x * gridDim.y * gridDim.z;
    unsigned sum, cnt, mine, sp = 0u;
    for (;;) {
        sum = 0u; cnt = 0u; mine = 0u;
#pragma unroll
        for (unsigned j = 0; j < 16; ++j) { const unsigned c = xb_ld(&bar[XB_XCNT(j)]); sum += c; cnt += (c > 0u) ? 1u : 0u; mine = (j == x) ? c : mine; }
        if (sum == G) break;
        __builtin_amdgcn_s_sleep(1);
        if ((++sp & 255u) == 0u) { if (xb_ld(&bar[XB_TMO])) break; if (sp > XB_SPIN_CAP) { atomicAdd(&bar[XB_TMO], 1u); break; } }
    }
    nloc = mine > 0u ? mine : 1u; nx = cnt > 0u ? cnt : 1u;
}

__device__ __forceinline__ void xcd_barrier(const XcdBarrier& b) {
    asm volatile("s_waitcnt vmcnt(0)" ::: "memory");
    __syncthreads();
    if (threadIdx.x == 0) {
        unsigned* bar = b.bar;
        __builtin_amdgcn_s_waitcnt(0);
        unsigned nloc = b.st[0], nx = b.st[1];
        if (nloc == 0u) { xcd_barrier_complete(bar, b.x, nloc, nx); b.st[0] = nloc; b.st[1] = nx; }
        const unsigned old = xb_add(&bar[XB_XSUB(b.x)], 1u);
        const unsigned gen = old / nloc;
        if (old + 1u == (gen + 1u) * nloc) {
            __builtin_amdgcn_fence(__ATOMIC_RELEASE, "agent");
            asm volatile("s_waitcnt vmcnt(0)" ::: "memory");
            const unsigned og = xb_add(&bar[XB_TOP], 1u);
            const unsigned tg = og / nx;
            if (og + 1u == (tg + 1u) * nx) xb_add(&bar[XB_TOPGEN], 1u);
            else XB_SPIN(xb_ld(&bar[XB_TOPGEN]) == tg, bar);
            __builtin_amdgcn_fence(__ATOMIC_ACQUIRE, "agent");
            xb_add(&bar[XB_XGEN(b.x)], 1u);
            asm volatile("s_waitcnt vmcnt(0)" ::: "memory");
        } else {
            XB_SPIN(xb_ld(&bar[XB_XGEN(b.x)]) == gen, bar);
            __builtin_amdgcn_fence(__ATOMIC_ACQUIRE, "agent");
            asm volatile("s_waitcnt vmcnt(0)" ::: "memory");
        }
    }
    __syncthreads();
}

constexpr int NWAVES = 8;
constexpr int SEQ = 8192, DM = 1024, MTOK = 16384, MCTX = 512, MALL = MTOK + MCTX, INW = 3328, DFF = 2816;
constexpr float EPS = 1e-6f;
constexpr float QSCALE = 0.125f * 1.4426950408889634f;
constexpr int RING_BYTES = 131072, LDSCTL_OFF = RING_BYTES, MISC_OFF = LDSCTL_OFF + 320, LDS_BYTES = 147456;

__device__ __forceinline__ float wave_sum(float v) {
#pragma unroll
    for (int o = 1; o < 64; o <<= 1) v += __shfl_xor(v, o);
    return v;
}
__device__ __forceinline__ float silu_f(float x) { return x * __builtin_amdgcn_rcpf(1.0f + __expf(-x)); }

__device__ __forceinline__ void p0_transpose_item(const float* W, int K, int N, bf16* WT, int ldw, int row_off, int koff, LAS float* scr, int item, int lane) {
    const int nblk = N / 32, kb = item / nblk, nb = item % nblk, k0 = 64 * kb, n0 = 32 * nb;
#pragma unroll 8
    for (int i = 0; i < 32; ++i) { const int kk = 2 * i + (lane >> 5); scr[kk * 33 + (lane & 31)] = W[(size_t)(k0 + kk) * N + n0 + (lane & 31)]; }
    LDS_WAIT(); asm volatile("" ::: "memory");
    const int c = lane & 7;
#pragma unroll
    for (int j = 0; j < 4; ++j) { const int n = (lane >> 3) + 8 * j; const LAS float* s = scr + (8 * c) * 33 + n;
        v4u o; o.x = pk2(s[0 * 33], s[1 * 33]); o.y = pk2(s[2 * 33], s[3 * 33]); o.z = pk2(s[4 * 33], s[5 * 33]); o.w = pk2(s[6 * 33], s[7 * 33]);
        *(v4u*)(WT + (size_t)(row_off + n0 + n) * ldw + koff + k0 + 8 * c) = o; }
    LDS_WAIT(); asm volatile("" ::: "memory");
}

struct Args {
    const float *x, *c, *ctx, *c_ctx, *w_mod, *b_mod, *g_pre1, *g_post1, *g_pre2, *g_post2, *w_in, *sink, *w_pa, *w_pf, *w_out, *w_up, *conv_w, *conv_b, *w_down;
    float* out; unsigned char* ws;
};

__device__ __forceinline__ void p0_prologue(const Args& A, LAS unsigned char* lds, int gw, int NGW, int wave, int lane, int tid) {
    unsigned char* ws = A.ws;
    bf16* WinT = (bf16*)(ws + WS_WIN); bf16* WupT = (bf16*)(ws + WS_WUP); bf16* WdnT = (bf16*)(ws + WS_WDN); bf16* WcatT = (bf16*)(ws + WS_WCAT); bf16* WoutT = (bf16*)(ws + WS_WOUT);
    bf16* TA = (bf16*)(ws + WS_TAB); bf16* TB = TA + TA_ELEMS;
    float* mod = (float*)(ws + WS_CTL) + CW_MOD;
    LAS float* TT = (LAS float*)(lds + 8 * 16384 - 1024);
    if (tid < 128) { TT[tid] = cospif((float)tid * (1.0f / 64.0f)); TT[128 + tid] = sinpif((float)tid * (1.0f / 64.0f)); }
    __syncthreads();
    for (int e = gw * 64 + lane; e < TA_ELEMS + TB_ELEMS; e += NGW * 64) {
        if (e < TA_ELEMS) {
            const int n = e >> 6, s1 = e & 63, T = n >> 4, c15 = n & 15, t = T >> 1, part = T & 1, k1 = 16 * t + c15, idx = (s1 * k1) & 63;
            const float a = (float)idx * (1.0f / 32.0f);
            TA[e] = (bf16)f2bf(part ? -sinpif(a) : cospif(a));
        } else {
            const int e2 = e - TA_ELEMS, n = e2 >> 8, K = e2 & 255, T = n >> 4, c15 = n & 15, t = T >> 1, pp = T & 1, k2 = 16 * t + c15, part = K >> 7, s2 = K & 127, idx = (s2 * k2) & 127;
            const float a = (float)idx * (1.0f / 64.0f); const float cv = cospif(a), sv = sinpif(a);
            TB[e2] = (bf16)f2bf(part == pp ? cv : (part == 1 ? sv : -sv));
        }
    }
    for (int it = NGW - 1 - gw; it < 512; it += NGW) {
        const int g = it & 3, nch = (it >> 2) & 15, cch = it >> 6, n = nch * 64 + lane, c0 = cch * 16;
        float ar[16], ai[16];
#pragma unroll
        for (int cc = 0; cc < 16; ++cc) { ar[cc] = 0.f; ai[cc] = 0.f; }
        const float* wp = A.w_pf + (size_t)(g * 128) * 1024 + n;
#pragma unroll 2
        for (int cp = 0; cp < 128; ++cp) {
            const float w = wp[(size_t)cp * 1024];
#pragma unroll
            for (int cc = 0; cc < 16; ++cc) { const int idx = ((c0 + cc) * cp) & 127; ar[cc] += TT[idx] * w; ai[cc] += TT[128 + idx] * w; }
        }
        bf16* dst = WcatT + (size_t)n * 1536 + 512 + g * 256 + c0;
        v4u o;
        o.x = pk2(ar[0] * (1.f / 1024.f), ar[1] * (1.f / 1024.f)); o.y = pk2(ar[2] * (1.f / 1024.f), ar[3] * (1.f / 1024.f)); o.z = pk2(ar[4] * (1.f / 1024.f), ar[5] * (1.f / 1024.f)); o.w = pk2(ar[6] * (1.f / 1024.f), ar[7] * (1.f / 1024.f));
        *(v4u*)dst = o;
        o.x = pk2(ar[8] * (1.f / 1024.f), ar[9] * (1.f / 1024.f)); o.y = pk2(ar[10] * (1.f / 1024.f), ar[11] * (1.f / 1024.f)); o.z = pk2(ar[12] * (1.f / 1024.f), ar[13] * (1.f / 1024.f)); o.w = pk2(ar[14] * (1.f / 1024.f), ar[15] * (1.f / 1024.f));
        *(v4u*)(dst + 8) = o;
        o.x = pk2(ai[0] * (1.f / 1024.f), ai[1] * (1.f / 1024.f)); o.y = pk2(ai[2] * (1.f / 1024.f), ai[3] * (1.f / 1024.f)); o.z = pk2(ai[4] * (1.f / 1024.f), ai[5] * (1.f / 1024.f)); o.w = pk2(ai[6] * (1.f / 1024.f), ai[7] * (1.f / 1024.f));
        *(v4u*)(dst + 128) = o;
        o.x = pk2(ai[8] * (1.f / 1024.f), ai[9] * (1.f / 1024.f)); o.y = pk2(ai[10] * (1.f / 1024.f), ai[11] * (1.f / 1024.f)); o.z = pk2(ai[12] * (1.f / 1024.f), ai[13] * (1.f / 1024.f)); o.w = pk2(ai[14] * (1.f / 1024.f), ai[15] * (1.f / 1024.f));
        *(v4u*)(dst + 136) = o;
    }
    for (int it = gw; it < 96 * 16; it += NGW) {
        const int cc = it % 96, kc = it / 96, col = cc * 64 + lane, k0 = kc * 64;
        const float s0 = silu_f(A.c[k0 + lane]), s1 = silu_f(A.c[1024 + k0 + lane]), s2 = silu_f(A.c_ctx[k0 + lane]);
        float a0 = 0.f, a1 = 0.f, a2 = 0.f;
        const float* wp = A.w_mod + (size_t)k0 * 6144 + col;
#pragma unroll 16
        for (int kk = 0; kk < 64; ++kk) {
            const float w = wp[(size_t)kk * 6144];
            a0 += __shfl(s0, kk) * w; a1 += __shfl(s1, kk) * w; a2 += __shfl(s2, kk) * w;
        }
        if (kc == 0) { const float b = A.b_mod[col]; a0 += b; a1 += b; a2 += b; }
        unsafeAtomicAdd(mod + col, a0); unsafeAtomicAdd(mod + 6144 + col, a1); unsafeAtomicAdd(mod + 2 * 6144 + col, a2);
    }
    LAS float* scr = (LAS float*)(lds + wave * 16384);
    constexpr int I_IN = 16 * (INW / 32), I_PA = 8 * 32, I_OUT = 16 * 32, I_UP = 16 * (2 * DFF / 32), I_DN = (DFF / 64) * 32;
    constexpr int NITEMS = I_IN + I_PA + I_OUT + I_UP + I_DN;
    for (int it = gw; it < NITEMS; it += NGW) {
        int r = it;
        if (r < I_IN) { p0_transpose_item(A.w_in, 1024, INW, WinT, 1024, 0, 0, scr, r, lane); continue; } r -= I_IN;
        if (r < I_PA) { p0_transpose_item(A.w_pa, 512, 1024, WcatT, 1536, 0, 0, scr, r, lane); continue; } r -= I_PA;
        if (r < I_OUT) { p0_transpose_item(A.w_out, 1024, 1024, WoutT, 1024, 0, 0, scr, r, lane); continue; } r -= I_OUT;
        if (r < I_UP) { p0_transpose_item(A.w_up, 1024, 2 * DFF, WupT, 1024, 0, 0, scr, r, lane); continue; } r -= I_UP;
        p0_transpose_item(A.w_down, DFF, 1024, WdnT, DFF, 0, 0, scr, r, lane);
    }
}

__device__ __forceinline__ void p1_norm(const Args& A, int gw, int NGW, int lane) {
    const float* mod = (const float*)(A.ws + WS_CTL) + CW_MOD;
    bf16* H = (bf16*)(A.ws + WS_H);
    for (int m = gw; m < MALL; m += NGW) {
        const float* xrow = m < MTOK ? A.x + (size_t)m * DM : A.ctx + (size_t)(m - MTOK) * DM;
        const int mi = m < MTOK ? (m >> 13) : 2;
        const f32x4* xr = (const f32x4*)xrow + lane;
        f32x4 v[4]; float s = 0.f;
#pragma unroll
        for (int j = 0; j < 4; ++j) { v[j] = xr[64 * j]; s += (v[j].x * v[j].x + v[j].y * v[j].y) + (v[j].z * v[j].z + v[j].w * v[j].w); }
        const float r = rsqrtf(wave_sum(s) * (1.f / DM) + EPS);
        unsigned long long* o8 = (unsigned long long*)(H + (size_t)m * DM) + lane;
#pragma unroll
        for (int j = 0; j < 4; ++j) {
            const f32x4 g = ((const f32x4*)A.g_pre1)[lane + 64 * j], sh = ((const f32x4*)(mod + mi * 6144))[lane + 64 * j], sc = ((const f32x4*)(mod + mi * 6144 + 1024))[lane + 64 * j];
            const f32x4 h = (v[j] * r) * g * (sc + 1.0f) + sh;
            o8[64 * j] = (unsigned long long)pk2(h.x, h.y) | ((unsigned long long)pk2(h.z, h.w) << 32);
        }
    }
}

__device__ __forceinline__ void attn_unit(const Args& A, LAS unsigned char* lds, int u, int wave, int lane, int tid) {
    const bf16* Q = (const bf16*)(A.ws + WS_Q); const bf16* Kb = (const bf16*)(A.ws + WS_K); const bf16* Vb = (const bf16*)(A.ws + WS_V);
    bf16* O = (bf16*)(A.ws + WS_ACAT);
    const int b = u >> 7, n = (u >> 1) & 63, h = u & 1;
    const int hq = h * 4 + (wave >> 1), qh = wave & 1;
    const int q0 = b * SEQ + n * 128 + qh * 64;
    const int fr = lane & 15, fq = lane >> 4;
    constexpr int KP = 72, VP = 136;
    LAS bf16* Ks = (LAS bf16*)lds; LAS bf16* Vt = (LAS bf16*)(lds + 128 * KP * 2);
    bf16x8 bq[4][2];
#pragma unroll
    for (int qt = 0; qt < 4; ++qt)
#pragma unroll
        for (int ks = 0; ks < 2; ++ks) bq[qt][ks] = *(const bf16x8*)(Q + (size_t)(q0 + qt * 16 + fr) * 512 + hq * 64 + ks * 32 + fq * 8);
    f32x4 oacc[4][4];
#pragma unroll
    for (int dt = 0; dt < 4; ++dt)
#pragma unroll
        for (int qt = 0; qt < 4; ++qt) oacc[dt][qt] = (f32x4){0.f, 0.f, 0.f, 0.f};
    float mrun[4], lrun[4];
#pragma unroll
    for (int qt = 0; qt < 4; ++qt) { mrun[qt] = -1e30f; lrun[qt] = 0.f; }
    for (int c = 0; c < 5; ++c) {
        int krow0;
        if (c < 3) { const int nb = n - 1 + c; if (nb < 0 || nb > 63) continue; krow0 = b * SEQ + nb * 128; }
        else krow0 = MTOK + b * 256 + (c - 3) * 128;
        __syncthreads();
        {
            const int row = tid >> 2, q4 = tid & 3;
            const bf16* kp = Kb + (size_t)(krow0 + row) * 128 + h * 64 + q4 * 16;
            const bf16* vp = Vb + (size_t)(krow0 + row) * 128 + h * 64 + q4 * 16;
            const v4u k0 = *(const v4u*)kp, k1 = *(const v4u*)(kp + 8), v0 = *(const v4u*)vp, v1 = *(const v4u*)(vp + 8);
            *(LAS v4u*)(Ks + row * KP + q4 * 16) = k0; *(LAS v4u*)(Ks + row * KP + q4 * 16 + 8) = k1;
            LAS bf16* vd = Vt + (q4 * 16) * VP + row;
            vd[0 * VP] = (bf16)(v0.x & 0xffff); vd[1 * VP] = (bf16)(v0.x >> 16); vd[2 * VP] = (bf16)(v0.y & 0xffff); vd[3 * VP] = (bf16)(v0.y >> 16);
            vd[4 * VP] = (bf16)(v0.z & 0xffff); vd[5 * VP] = (bf16)(v0.z >> 16); vd[6 * VP] = (bf16)(v0.w & 0xffff); vd[7 * VP] = (bf16)(v0.w >> 16);
            vd[8 * VP] = (bf16)(v1.x & 0xffff); vd[9 * VP] = (bf16)(v1.x >> 16); vd[10 * VP] = (bf16)(v1.y & 0xffff); vd[11 * VP] = (bf16)(v1.y >> 16);
            vd[12 * VP] = (bf16)(v1.z & 0xffff); vd[13 * VP] = (bf16)(v1.z >> 16); vd[14 * VP] = (bf16)(v1.w & 0xffff); vd[15 * VP] = (bf16)(v1.w >> 16);
        }
        __syncthreads();
        for (int sc = 0; sc < 4; ++sc) {
            f32x4 s[2][4];
#pragma unroll
            for (int kt = 0; kt < 2; ++kt) {
                const bf16x8 ka0 = *(const LAS bf16x8*)(Ks + (sc * 32 + kt * 16 + fr) * KP + fq * 8), ka1 = *(const LAS bf16x8*)(Ks + (sc * 32 + kt * 16 + fr) * KP + 32 + fq * 8);
#pragma unroll
                for (int qt = 0; qt < 4; ++qt) {
                    f32x4 z = (f32x4){0.f, 0.f, 0.f, 0.f};
                    z = __builtin_amdgcn_mfma_f32_16x16x32_bf16(ka0, bq[qt][0], z, 0, 0, 0);
                    s[kt][qt] = __builtin_amdgcn_mfma_f32_16x16x32_bf16(ka1, bq[qt][1], z, 0, 0, 0);
                }
            }
            if (c == 0 || c == 2) {
#pragma unroll
                for (int kt = 0; kt < 2; ++kt)
#pragma unroll
                    for (int qt = 0; qt < 4; ++qt) {
                        const int qidx = qh * 64 + qt * 16 + fr;
#pragma unroll
                        for (int r = 0; r < 4; ++r) { const int kidx = sc * 32 + kt * 16 + 4 * fq + r; const bool ok = (c == 0) ? (kidx >= qidx) : (kidx <= qidx); if (!ok) s[kt][qt][r] = -INFINITY; }
                    }
            }
            bf16x8 pf[4];
#pragma unroll
            for (int qt = 0; qt < 4; ++qt) {
                float mx = fmaxf(fmaxf(fmaxf(s[0][qt][0], s[0][qt][1]), fmaxf(s[0][qt][2], s[0][qt][3])), fmaxf(fmaxf(s[1][qt][0], s[1][qt][1]), fmaxf(s[1][qt][2], s[1][qt][3])));
                mx = fmaxf(mx, __shfl_xor(mx, 16)); mx = fmaxf(mx, __shfl_xor(mx, 32));
                const float mnew = fmaxf(mrun[qt], mx);
                const float alpha = __builtin_amdgcn_exp2f(mrun[qt] - mnew);
                mrun[qt] = mnew;
                float p[8]; float ps = 0.f;
#pragma unroll
                for (int r = 0; r < 4; ++r) { p[r] = __builtin_amdgcn_exp2f(s[0][qt][r] - mnew); p[4 + r] = __builtin_amdgcn_exp2f(s[1][qt][r] - mnew); ps += p[r] + p[4 + r]; }
                lrun[qt] = lrun[qt] * alpha + ps;
#pragma unroll
                for (int dt = 0; dt < 4; ++dt) oacc[dt][qt] = oacc[dt][qt] * alpha;
                v4u pw; pw.x = pg8::cvt_pk_bf16(p[0], p[1]); pw.y = pg8::cvt_pk_bf16(p[2], p[3]); pw.z = pg8::cvt_pk_bf16(p[4], p[5]); pw.w = pg8::cvt_pk_bf16(p[6], p[7]);
                pf[qt] = __builtin_bit_cast(bf16x8, pw);
            }
#pragma unroll
            for (int dt = 0; dt < 4; ++dt) {
                const LAS bf16* vrow = Vt + (dt * 16 + fr) * VP + sc * 32 + 4 * fq;
                const pg8::u32x2 vlo = *(const LAS pg8::u32x2*)vrow, vhi = *(const LAS pg8::u32x2*)(vrow + 16);
                const bf16x8 vfrag = __builtin_bit_cast(bf16x8, (v4u){vlo.x, vlo.y, vhi.x, vhi.y});
#pragma unroll
                for (int qt = 0; qt < 4; ++qt) oacc[dt][qt] = __builtin_amdgcn_mfma_f32_16x16x32_bf16(vfrag, pf[qt], oacc[dt][qt], 0, 0, 0);
            }
        }
    }
    const float sk = A.sink[hq] * 1.4426950408889634f;
#pragma unroll
    for (int qt = 0; qt < 4; ++qt) {
        float l = lrun[qt]; l += __shfl_xor(l, 16); l += __shfl_xor(l, 32);
        l += __builtin_amdgcn_exp2f(sk - mrun[qt]);
        const float inv = 1.0f / l;
        bf16* orow = O + (size_t)(q0 + qt * 16 + fr) * 1536 + hq * 64 + 4 * fq;
#pragma unroll
        for (int dt = 0; dt < 4; ++dt) {
            const f32x4 o = oacc[dt][qt] * inv;
            pg8::u32x2 w; w.x = pg8::cvt_pk_bf16(o[0], o[1]); w.y = pg8::cvt_pk_bf16(o[2], o[3]);
            *(pg8::u32x2*)(orow + dt * 16) = w;
        }
    }
}

__device__ __forceinline__ void ffta_item(const Args& A, LAS unsigned char* lds, int item, int wave, int lane, int tid) {
    const bf16* F = (const bf16*)(A.ws + WS_F); bf16* Y1 = (bf16*)(A.ws + WS_Y1);
    const bf16* TA = (const bf16*)(A.ws + WS_TAB);
    const int b = item >> 7, s2 = item & 127, fr = lane & 15, fq = lane >> 4;
    constexpr int XP = 514;
    LAS bf16* X = (LAS bf16*)lds;
    __syncthreads();
    for (int i = tid; i < 64 * 64; i += 512) {
        const int s1 = i >> 6, pc = i & 63;
        const v4u v = *(const v4u*)(F + (size_t)(b * SEQ + 128 * s1 + s2) * 512 + pc * 8);
        LAS unsigned* d = (LAS unsigned*)(X + s1 * XP + pc * 8);
        d[0] = v.x; d[1] = v.y; d[2] = v.z; d[3] = v.w;
    }
    __syncthreads();
    bf16x8 af[4][2];
#pragma unroll
    for (int mt = 0; mt < 4; ++mt)
#pragma unroll
        for (int ks = 0; ks < 2; ++ks) {
            const LAS bf16* p = X + (32 * ks + 8 * fq) * XP + wave * 64 + mt * 16 + fr;
            bf16x8 av;
#pragma unroll
            for (int j = 0; j < 8; ++j) av[j] = (short)p[j * XP];
            af[mt][ks] = av;
        }
#pragma unroll 1
    for (int nh = 0; nh < 2; ++nh) {
        f32x4 acc[4][4];
#pragma unroll
        for (int nt = 0; nt < 4; ++nt) {
            const bf16x8 b0 = *(const bf16x8*)(TA + (size_t)((nh * 4 + nt) * 16 + fr) * 64 + fq * 8), b1 = *(const bf16x8*)(TA + (size_t)((nh * 4 + nt) * 16 + fr) * 64 + 32 + fq * 8);
#pragma unroll
            for (int mt = 0; mt < 4; ++mt) {
                f32x4 z = (f32x4){0.f, 0.f, 0.f, 0.f};
                z = __builtin_amdgcn_mfma_f32_16x16x32_bf16(af[mt][0], b0, z, 0, 0, 0);
                acc[mt][nt] = __builtin_amdgcn_mfma_f32_16x16x32_bf16(af[mt][1], b1, z, 0, 0, 0);
            }
        }
#pragma unroll
        for (int tt = 0; tt < 2; ++tt) {
            const int k1 = 16 * (2 * nh + tt) + fr;
            const float a = (float)((s2 * k1) & 8191) * (1.0f / 4096.0f);
            const float cth = cospif(a), sth = sinpif(a);
            bf16* dst = Y1 + ((size_t)((b * 64 + k1) * 128 + s2)) * 1024 + wave * 64 + 4 * fq;
#pragma unroll
            for (int mt = 0; mt < 4; ++mt) {
                const f32x4 yr = acc[mt][2 * tt], yi = acc[mt][2 * tt + 1];
                const f32x4 zr = yr * cth + yi * sth, zi = yi * cth - yr * sth;
                pg8::u32x2 w; w.x = pg8::cvt_pk_bf16(zr[0], zr[1]); w.y = pg8::cvt_pk_bf16(zr[2], zr[3]);
                *(pg8::u32x2*)(dst + mt * 16) = w;
                w.x = pg8::cvt_pk_bf16(zi[0], zi[1]); w.y = pg8::cvt_pk_bf16(zi[2], zi[3]);
                *(pg8::u32x2*)(dst + 512 + mt * 16) = w;
            }
        }
    }
}

__device__ __forceinline__ void fftb_item(const Args& A, LAS unsigned char* lds, int item, int wave, int lane, int tid) {
    const bf16* Y1 = (const bf16*)(A.ws + WS_Y1); bf16* P = (bf16*)(A.ws + WS_ACAT);
    const bf16* TB = (const bf16*)(A.ws + WS_TAB) + TA_ELEMS;
    const int g = item & 3, k1 = (item >> 2) & 63, b = item >> 8, fr = lane & 15, fq = lane >> 4;
    constexpr int XP = 130;
    LAS bf16* X = (LAS bf16*)lds;
    __syncthreads();
    for (int i = tid; i < 256 * 16; i += 512) {
        const int K = i >> 4, pc = i & 15, part = K >> 7, s2 = K & 127;
        const v4u v = *(const v4u*)(Y1 + ((size_t)((b * 64 + k1) * 128 + s2)) * 1024 + part * 512 + g * 128 + pc * 8);
        LAS unsigned* d = (LAS unsigned*)(X + K * XP + pc * 8);
        d[0] = v.x; d[1] = v.y; d[2] = v.z; d[3] = v.w;
    }
    __syncthreads();
    const int wm = wave >> 2, wn = wave & 3;
    f32x4 acc[4][4];
#pragma unroll
    for (int mt = 0; mt < 4; ++mt)
#pragma unroll
        for (int nt = 0; nt < 4; ++nt) acc[mt][nt] = (f32x4){0.f, 0.f, 0.f, 0.f};
#pragma unroll 2
    for (int ks = 0; ks < 8; ++ks) {
        bf16x8 af[4], bfr[4];
#pragma unroll
        for (int nt = 0; nt < 4; ++nt) bfr[nt] = *(const bf16x8*)(TB + (size_t)((wn * 4 + nt) * 16 + fr) * 256 + ks * 32 + fq * 8);
#pragma unroll
        for (int mt = 0; mt < 4; ++mt) {
            const LAS bf16* p = X + (32 * ks + 8 * fq) * XP + (wm * 4 + mt) * 16 + fr;
            bf16x8 av;
#pragma unroll
            for (int j = 0; j < 8; ++j) av[j] = (short)p[j * XP];
            af[mt] = av;
        }
#pragma unroll
        for (int mt = 0; mt < 4; ++mt)
#pragma unroll
            for (int nt = 0; nt < 4; ++nt) acc[mt][nt] = __builtin_amdgcn_mfma_f32_16x16x32_bf16(af[mt], bfr[nt], acc[mt][nt], 0, 0, 0);
    }
#pragma unroll
    for (int nt = 0; nt < 4; ++nt) {
        const int T = 4 * wn + nt, t = T >> 1, pp = T & 1, k2 = 16 * t + fr, sp = k1 + 64 * k2;
        bf16* dst = P + (size_t)(b * SEQ + sp) * 1536 + 512 + g * 256 + pp * 128 + wm * 64 + 4 * fq;
#pragma unroll
        for (int mt = 0; mt < 4; ++mt) {
            const f32x4 z = acc[mt][nt];
            pg8::u32x2 w; w.x = pg8::cvt_pk_bf16(z[0], z[1]); w.y = pg8::cvt_pk_bf16(z[2], z[3]);
            *(pg8::u32x2*)(dst + mt * 16) = w;
        }
    }
}

__device__ __forceinline__ void p7_res_norm(const Args& A, int gw, int NGW, int lane) {
    const float* mod = (const float*)(A.ws + WS_CTL) + CW_MOD;
    const bf16* Y = (const bf16*)(A.ws + WS_YB); bf16* H = (bf16*)(A.ws + WS_H);
    for (int m = gw; m < MTOK; m += NGW) {
        const float* mb = mod + (m >> 13) * 6144;
        const unsigned long long* yr = (const unsigned long long*)(Y + (size_t)m * DM) + lane;
        f32x4 y[4]; float s = 0.f;
#pragma unroll
        for (int j = 0; j < 4; ++j) { const unsigned long long w = yr[64 * j]; const unsigned lo = (unsigned)w, hi = (unsigned)(w >> 32);
            y[j] = (f32x4){pg8::bf_lo(lo), pg8::bf_hi(lo), pg8::bf_lo(hi), pg8::bf_hi(hi)}; s += (y[j].x * y[j].x + y[j].y * y[j].y) + (y[j].z * y[j].z + y[j].w * y[j].w); }
        const float r = rsqrtf(wave_sum(s) * (1.f / DM) + EPS);
        f32x4 x1[4]; float s2 = 0.f;
#pragma unroll
        for (int j = 0; j < 4; ++j) {
            const f32x4 xv = ((const f32x4*)(A.x + (size_t)m * DM))[lane + 64 * j], g = ((const f32x4*)A.g_post1)[lane + 64 * j], gt = ((const f32x4*)(mb + 2048))[lane + 64 * j];
            x1[j] = xv + gt * ((y[j] * r) * g);
            ((f32x4*)(A.out + (size_t)m * DM))[lane + 64 * j] = x1[j];
            s2 += (x1[j].x * x1[j].x + x1[j].y * x1[j].y) + (x1[j].z * x1[j].z + x1[j].w * x1[j].w);
        }
        const float r2 = rsqrtf(wave_sum(s2) * (1.f / DM) + EPS);
        unsigned long long* o8 = (unsigned long long*)(H + (size_t)m * DM) + lane;
#pragma unroll
        for (int j = 0; j < 4; ++j) {
            const f32x4 g = ((const f32x4*)A.g_pre2)[lane + 64 * j], sh = ((const f32x4*)(mb + 3072))[lane + 64 * j], sc = ((const f32x4*)(mb + 4096))[lane + 64 * j];
            const f32x4 h = (x1[j] * r2) * g * (sc + 1.0f) + sh;
            o8[64 * j] = (unsigned long long)pk2(h.x, h.y) | ((unsigned long long)pk2(h.z, h.w) << 32);
        }
    }
}

__device__ __forceinline__ void up8(const v4u v, float (&f)[8]) {
    f[0] = pg8::bf_lo(v.x); f[1] = pg8::bf_hi(v.x); f[2] = pg8::bf_lo(v.y); f[3] = pg8::bf_hi(v.y); f[4] = pg8::bf_lo(v.z); f[5] = pg8::bf_hi(v.z); f[6] = pg8::bf_lo(v.w); f[7] = pg8::bf_hi(v.w);
}
__device__ __forceinline__ void p9_conv_act(const Args& A, int gthread, int nthreads) {
    const bf16* U = (const bf16*)(A.ws + WS_U); bf16* G = (bf16*)(A.ws + WS_G);
    constexpr int NCO = DFF / 8, RUN = 16, NRUN = MTOK / RUN;
    for (int it = gthread; it < NCO * NRUN; it += nthreads) {
        const int co = it % NCO, run = it / NCO, col = co * 8, m0 = run * RUN;
        float w0[8], w1[8], w2[8], bb[8];
#pragma unroll
        for (int j = 0; j < 8; ++j) { w0[j] = A.conv_w[col + j]; w1[j] = A.conv_w[DFF + col + j]; w2[j] = A.conv_w[2 * DFF + col + j]; bb[j] = A.conv_b[col + j]; }
        float up[8], uc[8], un[8];
        const v4u zero = (v4u){0u, 0u, 0u, 0u};
        up8(((m0 & (SEQ - 1)) == 0) ? zero : *(const v4u*)(U + (size_t)(m0 - 1) * DFF + col), up);
        up8(*(const v4u*)(U + (size_t)m0 * DFF + col), uc);
#pragma unroll 4
        for (int i = 0; i < RUN; ++i) {
            const int m = m0 + i;
            up8((((m + 1) & (SEQ - 1)) == 0) ? zero : *(const v4u*)(U + (size_t)(m + 1) * DFF + col), un);
            float gv[8]; up8(*(const v4u*)(G + (size_t)m * DFF + col), gv);
            float a[8];
#pragma unroll
            for (int j = 0; j < 8; ++j) { const float cv = up[j] * w0[j] + uc[j] * w1[j] + un[j] * w2[j] + bb[j]; a[j] = silu_f(cv) * gv[j]; up[j] = uc[j]; uc[j] = un[j]; }
            v4u o; o.x = pk2(a[0], a[1]); o.y = pk2(a[2], a[3]); o.z = pk2(a[4], a[5]); o.w = pk2(a[6], a[7]);
            *(v4u*)(G + (size_t)m * DFF + col) = o;
        }
    }
}

__device__ __forceinline__ void p11_final(const Args& A, int gw, int NGW, int lane) {
    const float* mod = (const float*)(A.ws + WS_CTL) + CW_MOD;
    const bf16* Z = (const bf16*)(A.ws + WS_ZB);
    for (int m = gw; m < MTOK; m += NGW) {
        const float* mb = mod + (m >> 13) * 6144;
        const unsigned long long* zr = (const unsigned long long*)(Z + (size_t)m * DM) + lane;
        f32x4 z[4]; float s = 0.f;
#pragma unroll
        for (int j = 0; j < 4; ++j) { const unsigned long long w = zr[64 * j]; const unsigned lo = (unsigned)w, hi = (unsigned)(w >> 32);
            z[j] = (f32x4){pg8::bf_lo(lo), pg8::bf_hi(lo), pg8::bf_lo(hi), pg8::bf_hi(hi)}; s += (z[j].x * z[j].x + z[j].y * z[j].y) + (z[j].z * z[j].z + z[j].w * z[j].w); }
        const float r = rsqrtf(wave_sum(s) * (1.f / DM) + EPS);
#pragma unroll
        for (int j = 0; j < 4; ++j) {
            f32x4* op = (f32x4*)(A.out + (size_t)m * DM) + lane + 64 * j;
            const f32x4 g = ((const f32x4*)A.g_post2)[lane + 64 * j], gt = ((const f32x4*)(mb + 5120))[lane + 64 * j];
            *op = *op + gt * ((z[j] * r) * g);
        }
    }
}

__global__ void __launch_bounds__(NWAVES * 64, 2) fwd_megakernel(Args A) {
    extern __shared__ __attribute__((aligned(16))) unsigned char lds_raw[];
    LAS unsigned char* lds = (LAS unsigned char*)lds_raw;
    volatile LAS unsigned* MISC = (volatile LAS unsigned*)(lds + MISC_OFF);
    const int tid = threadIdx.x;
#define FRESH() int tid_ = threadIdx.x; asm volatile("" : "+v"(tid_)); const int lane_ = tid_ & 63, wave_ = __builtin_amdgcn_readfirstlane(tid_ >> 6), gw_ = vcu * NWAVES + wave_
    const int G = gridDim.x, bx = blockIdx.x, vcu = (G % 8 == 0) ? (bx % 8) * (G / 8) + bx / 8 : bx;
    const int NGW = G * NWAVES;
    unsigned* ctl = (unsigned*)(A.ws + WS_CTL);
    for (int u = tid; u < (LDS_BYTES - LDSCTL_OFF) / 4; u += NWAVES * 64) ((LAS unsigned*)(lds + LDSCTL_OFF))[u] = 0u;
    __syncthreads();
    XcdBarrier bar = xcd_barrier_post(ctl + CW_BAR, MISC + 8);
    unsigned char* ws = A.ws;

    { FRESH(); p0_prologue(A, lds, gw_, NGW, wave_, lane_, tid_); }
    xcd_barrier(bar);
    { FRESH(); p1_norm(A, gw_, NGW, lane_); }
    xcd_barrier(bar);
    {
        pg8::Gemm g{(const pg8::bf16_t*)(ws + WS_H), (const pg8::bf16_t*)(ws + WS_WIN), MALL, INW, 1024};
        pg8::OrderIn S; S.init(G, bx);
        pg8::EpiIn E{(pg8::bf16_t*)ws, QSCALE};
        pg8::gemm_phase<pg8::EpiIn, pg8::OrderIn, true, true>(lds, g, S, E);
    }
    xcd_barrier(bar);
    { FRESH(); for (int u = bx; u < 256; u += G) attn_unit(A, lds, u, wave_, lane_, tid_); }
    { FRESH(); for (int it = bx; it < 256; it += G) ffta_item(A, lds, it, wave_, lane_, tid_); }
    xcd_barrier(bar);
    { FRESH(); for (int it = bx; it < 512; it += G) fftb_item(A, lds, it, wave_, lane_, tid_); }
    xcd_barrier(bar);
    {
        pg8::Gemm g{(const pg8::bf16_t*)(ws + WS_ACAT), (const pg8::bf16_t*)(ws + WS_WCAT), MTOK, 1024, 1536};
        pg8::StaticOrder S; S.init(MTOK, 1024, G, bx);
        pg8::EpiMerge E{(const pg8::bf16_t*)(ws + WS_GA), (const pg8::bf16_t*)(ws + WS_GF), (pg8::bf16_t*)(ws + WS_MB)};
        pg8::gemm_phase<pg8::EpiMerge, pg8::StaticOrder, true, true>(lds, g, S, E);
    }
    xcd_barrier(bar);
    {
        pg8::Gemm g{(const pg8::bf16_t*)(ws + WS_MB), (const pg8::bf16_t*)(ws + WS_WOUT), MTOK, 1024, 1024};
        pg8::StaticOrder S; S.init(MTOK, 1024, G, bx);
        pg8::EpiBf16 E{(pg8::bf16_t*)(ws + WS_YB), 1024, 0, 0};
        pg8::gemm_phase<pg8::EpiBf16, pg8::StaticOrder, true, true>(lds, g, S, E);
    }
    xcd_barrier(bar);
    { FRESH(); p7_res_norm(A, gw_, NGW, lane_); }
    xcd_barrier(bar);
    {
        pg8::Gemm g{(const pg8::bf16_t*)(ws + WS_H), (const pg8::bf16_t*)(ws + WS_WUP), MTOK, 2 * DFF, 1024};
        pg8::StaticOrder S; S.init(MTOK, 2 * DFF, G, bx);
        pg8::EpiBf16 E{(pg8::bf16_t*)(ws + WS_U), DFF, DFF, (size_t)(WS_G - WS_U) / 2};
        pg8::gemm_phase<pg8::EpiBf16, pg8::StaticOrder, true, true>(lds, g, S, E);
    }
    xcd_barrier(bar);
    { FRESH(); p9_conv_act(A, gw_ * 64 + lane_, NGW * 64); }
    xcd_barrier(bar);
    {
        pg8::Gemm g{(const pg8::bf16_t*)(ws + WS_G), (const pg8::bf16_t*)(ws + WS_WDN), MTOK, 1024, DFF};
        pg8::StaticOrder S; S.init(MTOK, 1024, G, bx);
        pg8::EpiBf16 E{(pg8::bf16_t*)(ws + WS_ZB), 1024, 0, 0};
        pg8::gemm_phase<pg8::EpiBf16, pg8::StaticOrder, true, true>(lds, g, S, E);
    }
    xcd_barrier(bar);
    { FRESH(); p11_final(A, gw_, NGW, lane_); }
}

extern "C" void kernel_launch(void* const* d_in, const int* in_sizes, int n_in, void* d_out, int out_size, void* d_ws, size_t ws_size, hipStream_t stream) {
    static int grid = 0;
    if (grid == 0) {
        if (n_in != 19 || ws_size < WS_END) { fprintf(stderr, "kernel_launch: unexpected inputs (n_in %d, ws %zu)\n", n_in, ws_size); grid = -1; return; }
        int dev = 0, cus = 0, per_cu = 0;
        if (hipGetDevice(&dev) != hipSuccess || hipDeviceGetAttribute(&cus, hipDeviceAttributeMultiprocessorCount, dev) != hipSuccess) { grid = -1; return; }
        if (hipFuncSetAttribute((const void*)fwd_megakernel, hipFuncAttributeMaxDynamicSharedMemorySize, LDS_BYTES) != hipSuccess) { fprintf(stderr, "kernel_launch: hipFuncSetAttribute failed\n"); grid = -1; return; }
        if (hipOccupancyMaxActiveBlocksPerMultiprocessor(&per_cu, (const void*)fwd_megakernel, NWAVES * 64, LDS_BYTES) != hipSuccess || per_cu < 1) { fprintf(stderr, "kernel_launch: occupancy query reports %d\n", per_cu); }
        (void)hipGetLastError();
        grid = cus;
    }
    if (grid < 0) return;
    if (hipMemsetAsync((char*)d_ws + WS_CTL, 0, CTL_ZERO_BYTES, stream) != hipSuccess) return;
    Args a{};
    const float** ap = (const float**)&a;
    for (int i = 0; i < 19; ++i) ap[i] = (const float*)d_in[i];
    a.out = (float*)d_out; a.ws = (unsigned char*)d_ws;
    hipLaunchKernelGGL(fwd_megakernel, dim3(grid), dim3(NWAVES * 64), LDS_BYTES, stream, a);
}
```

```cpp
#include <cstddef>
constexpr size_t MiB = 1u << 20;
constexpr size_t WS_CTL = 0, CTL_ZERO_BYTES = 1 * MiB;
constexpr size_t WS_WIN = 1 * MiB, WS_WUP = 8 * MiB, WS_WDN = 19 * MiB, WS_WCAT = 25 * MiB, WS_WOUT = 28 * MiB, WS_TAB = 30 * MiB;
constexpr size_t WS_H = 31 * MiB;
constexpr size_t WS_Q = 65 * MiB, WS_K = 81 * MiB, WS_V = 86 * MiB, WS_F = 91 * MiB, WS_Y1 = 107 * MiB, WS_ACAT = 139 * MiB, WS_GA = 187 * MiB, WS_GF = 219 * MiB;
constexpr size_t WS_MB = 65 * MiB;
constexpr size_t WS_YB = 107 * MiB;
constexpr size_t WS_U = 65 * MiB, WS_G = 153 * MiB;
constexpr size_t WS_ZB = 65 * MiB;
constexpr size_t WS_END = 251 * MiB;
constexpr int CW_BAR = 4096;
constexpr int CW_MOD = 32768;
constexpr int TA_ELEMS = 128 * 64, TB_ELEMS = 256 * 256;
constexpr int CW_PCNT = 12288;
constexpr int CW_FCNT = 8192;
constexpr int CW_RS1 = 65536, CW_RS2 = 81920, CW_RS3 = 98304;
#include <hip/hip_runtime.h>
#include <cstdio>
#include <cstdint>
namespace pg8 {
#define PG8_LAS __attribute__((address_space(3)))
typedef unsigned short bf16_t;
typedef short bf16x8 __attribute__((ext_vector_type(8)));
typedef float f32x4 __attribute__((ext_vector_type(4)));
typedef unsigned u32x4 __attribute__((ext_vector_type(4)));
constexpr int BM = 256, BK = 64, HALF = 128, HTB = HALF * BK * 2  , STAGE_BYTES = 8 * HTB, NXCD = 8, WGM = 8;

__host__ __device__ __forceinline__ int lds_byte(int r, int c) { const int st = (r >> 4) * 2 + (c >> 5), rr = r & 15, cc = c & 31, ob = rr * 64 + cc * 2; return st * 1024 + (ob ^ (((ob >> 9) & 1) << 5)); }
__host__ __device__ __forceinline__ void stage_rc(int b, int& R, int& C) { const int st = b / 1024, sb = b % 1024, swz = sb ^ (((sb >> 9) & 1) << 5); R = (st >> 1) * 16 + swz / 64; C = (st & 1) * 32 + (swz % 64) / 2; }
__host__ __device__ __forceinline__ int perm32(int rho) { const int n = rho >> 4, i = rho & 15; return 8 * (i >> 2) + 4 * n + (i & 3); }

struct Unit { int pm, pn; };
struct Gemm { const bf16_t* A; const bf16_t* Bt; int M, N, K; int strip; };

struct StaticOrder {
    int nM, nN, nwg, G, c;
    __host__ __device__ void init(int M, int N, int G_, int c_) { nM = M / BM; nN = N / BM; nwg = nM * nN; G = G_; c = c_; }
    __host__ __device__ bool next(int i, Unit& u) const {
        const long L = (long)i * G + c; if (L >= nwg) return false;
        int wgid = (int)L; { const int q = nwg / NXCD, r = nwg % NXCD, xcd = wgid % NXCD, off = wgid / NXCD; wgid = (xcd < r ? xcd * (q + 1) : r * (q + 1) + (xcd - r) * q) + off; }
        const int nig = WGM * nN, gid = wgid / nig, fm = gid * WGM, gsz = (nM - fm) < WGM ? (nM - fm) : WGM;
        u.pm = fm + ((wgid % nig) % gsz); u.pn = (wgid % nig) / gsz; return true;
    }
    __device__ __forceinline__ void a_ready(const Unit&) const {}
    __device__ __forceinline__ void done(const Unit&) const {}
};

typedef __bf16 bf16x2n_t __attribute__((ext_vector_type(2)));
typedef float f32x2n_t __attribute__((ext_vector_type(2)));
__device__ __forceinline__ unsigned cvt_pk_bf16(float lo, float hi) { const f32x2n_t v = {lo, hi}; const bf16x2n_t r = __builtin_convertvector(v, bf16x2n_t); return __builtin_bit_cast(unsigned, r); }
typedef float f32x2 __attribute__((ext_vector_type(2)));
typedef unsigned u32x2 __attribute__((ext_vector_type(2)));
__device__ __forceinline__ float bf_lo(unsigned w) { return __uint_as_float(w << 16); }
__device__ __forceinline__ float bf_hi(unsigned w) { return __uint_as_float(w & 0xffff0000u); }
__device__ __forceinline__ float sigmoid_f(float x) { return __builtin_amdgcn_rcpf(1.0f + __expf(-x)); }

struct EpiBf16 {
    static constexpr bool PERM = true, AFTER_DRAIN = false; static constexpr int MID_T = 0;
    bf16_t* O; int ldc; int split_cols; size_t split_stride;
    __device__ __forceinline__ void operator()(const f32x4 (&acc)[2][2][4][2], const Unit& u, int wr, int wc, int fr, int fq) const {
        const int row0 = u.pm * BM + wr * 64 + fr; int colt = u.pn * BM; bf16_t* base = O;
        if (split_cols) { const int t = colt / split_cols; base += (size_t)t * split_stride; colt -= t * split_cols; }
        const int col0 = colt + wc * 32 + 8 * fq;
#pragma unroll
        for (int ai = 0; ai < 2; ++ai)
#pragma unroll
            for (int m = 0; m < 4; ++m) { bf16_t* rowp = base + (size_t)(row0 + ai * HALF + m * 16) * ldc + col0;
#pragma unroll
                for (int bj = 0; bj < 2; ++bj) { const f32x4 v0 = acc[ai][bj][m][0], v1 = acc[ai][bj][m][1];
                    u32x4 w; w.x = cvt_pk_bf16(v0[0], v0[1]); w.y = cvt_pk_bf16(v0[2], v0[3]); w.z = cvt_pk_bf16(v1[0], v1[1]); w.w = cvt_pk_bf16(v1[2], v1[3]);
                    *(u32x4*)(rowp + bj * HALF) = w; } }
    }
};

struct EpiIn {
    static constexpr bool PERM = false, AFTER_DRAIN = false; static constexpr int MID_T = 0;
    bf16_t* base0; float qscale; unsigned* fcnt;
    static constexpr unsigned oQ = WS_Q / 2, oK = WS_K / 2, oV = WS_V / 2, oF = WS_F / 2, oGA = WS_GA / 2, oGF = WS_GF / 2;
    __device__ __forceinline__ void operator()(const f32x4 (&acc)[2][2][4][2], const Unit& u, int wr, int wc, int fr, int fq) const {
        const int pn = u.pn;
        const int row0 = u.pm * BM + wr * 64 + fr;
        if (pn <= 2) {
            float invf[4];
#pragma unroll
            for (int j = 0; j < 4; ++j) invf[j] = exp2f(-(float)(4 * fq + j) * 0.830482023f) * 0.15915494309f;
#pragma unroll
            for (int ai = 0; ai < 2; ++ai)
#pragma unroll
                for (int m = 0; m < 4; ++m) {
                    const int row = row0 + ai * HALF + m * 16;
                    const int t = row & 8191; const float pos = (float)((wc & 1) ? (t & 63) : (t >> 6));
                    float cs[4], sn[4];
#pragma unroll
                    for (int j = 0; j < 4; ++j) { const float rev = pos * invf[j]; const float fr_ = rev - floorf(rev); cs[j] = __builtin_amdgcn_cosf(fr_); sn[j] = __builtin_amdgcn_sinf(fr_); }
#pragma unroll
                    for (int bj = 0; bj < 2; ++bj) {
                        f32x4 v0 = acc[ai][bj][m][0], v1 = acc[ai][bj][m][1];
                        const bool rope = (pn < 2) || (bj == 0 && row < 16384);
                        if (rope) {
#pragma unroll
                            for (int j = 0; j < 4; ++j) { const float a = v0[j], b = v1[j]; v0[j] = a * cs[j] - b * sn[j]; v1[j] = b * cs[j] + a * sn[j]; }
                        }
                        unsigned doff;
                        if (pn < 2) { v0 = v0 * qscale; v1 = v1 * qscale; doff = oQ + (unsigned)row * 512u + pn * 256 + bj * HALF + wc * 32 + 4 * fq; }
                        else doff = (bj == 0 ? oK : oV) + (unsigned)row * 128u + wc * 32 + 4 * fq;
                        bf16_t* dst = base0 + doff;
                        u32x2 w0, w1; w0.x = cvt_pk_bf16(v0[0], v0[1]); w0.y = cvt_pk_bf16(v0[2], v0[3]); w1.x = cvt_pk_bf16(v1[0], v1[1]); w1.y = cvt_pk_bf16(v1[2], v1[3]);
                        *(u32x2*)dst = w0; *(u32x2*)(dst + 16) = w1;
                    }
                }
        } else {
            const bool isf = pn <= 4;
            unsigned boff; int ldc, colt;
            if (isf) { boff = oF; ldc = 512; colt = (pn - 3) * 256; }
            else if (pn <= 8) { boff = oGA; ldc = 1024; colt = (pn - 5) * 256; }
            else { boff = oGF; ldc = 1024; colt = (pn - 9) * 256; }
            bf16_t* base = base0 + boff;
#pragma unroll
            for (int ai = 0; ai < 2; ++ai)
#pragma unroll
                for (int m = 0; m < 4; ++m) {
                    bf16_t* rowp = base + (size_t)(row0 + ai * HALF + m * 16) * ldc + colt + wc * 32 + 4 * fq;
#pragma unroll
                    for (int bj = 0; bj < 2; ++bj)
#pragma unroll
                        for (int n = 0; n < 2; ++n) {
                            f32x4 v = acc[ai][bj][m][n];
                            if (!isf) { v[0] = sigmoid_f(v[0]); v[1] = sigmoid_f(v[1]); v[2] = sigmoid_f(v[2]); v[3] = sigmoid_f(v[3]); }
                            u32x2 w; w.x = cvt_pk_bf16(v[0], v[1]); w.y = cvt_pk_bf16(v[2], v[3]);
                            if (isf) __hip_atomic_store((unsigned long long*)(rowp + bj * HALF + n * 16), ((unsigned long long)w.y << 32) | w.x, __ATOMIC_RELAXED, __HIP_MEMORY_SCOPE_AGENT);
                            else *(u32x2*)(rowp + bj * HALF + n * 16) = w;
                        }
                }
            if (isf) {
                asm volatile("s_waitcnt vmcnt(0)" ::: "memory");
                if (fr == 0 && fq == 0) __hip_atomic_fetch_add(fcnt, 1u, __ATOMIC_RELAXED, __HIP_MEMORY_SCOPE_AGENT);
            }
        }
    }
};

struct EpiMerge {
    static constexpr bool PERM = true, AFTER_DRAIN = false; static constexpr int MID_T = 8;
    const bf16_t *GA, *GF; bf16_t* O;
    __device__ __forceinline__ void mid(f32x4 (&acc)[2][2][4][2], const Unit& u, int wr, int wc, int fr, int fq) const {
        const unsigned loff = (unsigned)(wr * 64 + fr) * 1024u + wc * 32 + 8 * fq;
        const size_t uoff = (size_t)(__builtin_amdgcn_readfirstlane(u.pm) * BM) * 1024 + __builtin_amdgcn_readfirstlane(u.pn) * BM;
#pragma unroll
        for (int ai = 0; ai < 2; ++ai)
#pragma unroll
            for (int m = 0; m < 4; ++m) { const bf16_t* pa = GA + uoff + (size_t)(ai * HALF + m * 16) * 1024; const bf16_t* pf = GF + uoff + (size_t)(ai * HALF + m * 16) * 1024;
#pragma unroll
                for (int bj = 0; bj < 2; ++bj) {
                    const u32x4 a = __builtin_nontemporal_load((const u32x4*)(pa + bj * HALF + loff)), f = *(const u32x4*)(pf + bj * HALF + loff);
                    f32x4 r0, r1;
                    r0[0] = bf_lo(a.x) * __builtin_amdgcn_rcpf(bf_lo(f.x)); r0[1] = bf_hi(a.x) * __builtin_amdgcn_rcpf(bf_hi(f.x));
                    r0[2] = bf_lo(a.y) * __builtin_amdgcn_rcpf(bf_lo(f.y)); r0[3] = bf_hi(a.y) * __builtin_amdgcn_rcpf(bf_hi(f.y));
                    r1[0] = bf_lo(a.z) * __builtin_amdgcn_rcpf(bf_lo(f.z)); r1[1] = bf_hi(a.z) * __builtin_amdgcn_rcpf(bf_hi(f.z));
                    r1[2] = bf_lo(a.w) * __builtin_amdgcn_rcpf(bf_lo(f.w)); r1[3] = bf_hi(a.w) * __builtin_amdgcn_rcpf(bf_hi(f.w));
                    acc[ai][bj][m][0] = acc[ai][bj][m][0] * r0; acc[ai][bj][m][1] = acc[ai][bj][m][1] * r1;
                }
                asm volatile("" : "+v"(acc[ai][0][m][0]), "+v"(acc[ai][0][m][1]), "+v"(acc[ai][1][m][0]), "+v"(acc[ai][1][m][1]));
                asm volatile("" ::: "memory"); }
    }
    __device__ __forceinline__ void operator()(const f32x4 (&acc)[2][2][4][2], const Unit& u, int wr, int wc, int fr, int fq) const {
        const unsigned loff = (unsigned)(wr * 64 + fr) * 1024u + wc * 32 + 8 * fq;
        const size_t uoff = (size_t)(__builtin_amdgcn_readfirstlane(u.pm) * BM) * 1024 + __builtin_amdgcn_readfirstlane(u.pn) * BM;
#pragma unroll
        for (int ai = 0; ai < 2; ++ai)
#pragma unroll
            for (int m = 0; m < 4; ++m) { const bf16_t* pf = GF + uoff + (size_t)(ai * HALF + m * 16) * 1024; bf16_t* po = O + uoff + (size_t)(ai * HALF + m * 16) * 1024;
#pragma unroll
                for (int bj = 0; bj < 2; ++bj) {
                    const u32x4 f = *(const u32x4*)(pf + bj * HALF + loff);
                    const f32x4 v0 = acc[ai][bj][m][0], v1 = acc[ai][bj][m][1];
                    u32x4 w;
                    w.x = cvt_pk_bf16(v0[0] * bf_lo(f.x), v0[1] * bf_hi(f.x)); w.y = cvt_pk_bf16(v0[2] * bf_lo(f.y), v0[3] * bf_hi(f.y));
                    w.z = cvt_pk_bf16(v1[0] * bf_lo(f.z), v1[1] * bf_hi(f.z)); w.w = cvt_pk_bf16(v1[2] * bf_lo(f.w), v1[3] * bf_hi(f.w));
                    *(u32x4*)(po + bj * HALF + loff) = w;
                }
                asm volatile("" ::: "memory"); }
    }
};


__device__ __forceinline__ float dpp_ror1(float x) { return __int_as_float(__builtin_amdgcn_mov_dpp(__float_as_int(x), 0x121, 0xf, 0xf, true)); }
__device__ __forceinline__ float dpp_rol1(float x) { return __int_as_float(__builtin_amdgcn_mov_dpp(__float_as_int(x), 0x12f, 0xf, 0xf, true)); }
struct EpiUp {
    static constexpr bool PERM = true, AFTER_DRAIN = false; static constexpr int MID_T = 0;
    const float* cw; const float* cb; bf16_t* O;
    __device__ __forceinline__ void operator()(const f32x4 (&acc)[2][2][4][2], const Unit& u, int wr, int wc, int fr, int fq) const {
        const int pm = __builtin_amdgcn_readfirstlane(u.pm), pn = __builtin_amdgcn_readfirstlane(u.pn);
        const int ch0 = pn * 128 + wc * 32 + 8 * fq;
        float w0[8], w1[8], w2[8], bb[8];
#pragma unroll
        for (int h = 0; h < 2; ++h) {
            const f32x4 a = *(const f32x4*)(cw + ch0 + 4 * h), b = *(const f32x4*)(cw + 2816 + ch0 + 4 * h), c = *(const f32x4*)(cw + 2 * 2816 + ch0 + 4 * h), d = *(const f32x4*)(cb + ch0 + 4 * h);
#pragma unroll
            for (int j = 0; j < 4; ++j) { w0[4 * h + j] = a[j]; w1[4 * h + j] = b[j]; w2[4 * h + j] = c[j]; bb[4 * h + j] = d[j]; }
        }
#pragma unroll
        for (int ai = 0; ai < 2; ++ai) {
            const int tok0 = 248 * pm + 62 * (2 * ai + wr) - 1 + fr;
            float av[4][8];
#pragma unroll
            for (int n = 0; n < 2; ++n)
#pragma unroll
                for (int j = 0; j < 4; ++j) {
                    float uu[4], rr[4], ll[4];
#pragma unroll
                    for (int m = 0; m < 4; ++m) { uu[m] = acc[ai][0][m][n][j]; rr[m] = dpp_ror1(uu[m]); ll[m] = dpp_rol1(uu[m]); }
#pragma unroll
                    for (int m = 0; m < 4; ++m) {
                        float pv = (fr == 0) ? (m > 0 ? rr[m > 0 ? m - 1 : 0] : 0.f) : rr[m];
                        float nx = (fr == 15) ? (m < 3 ? ll[m < 3 ? m + 1 : 3] : 0.f) : ll[m];
                        const int sb = (tok0 + 16 * m) & 8191;
                        if (sb == 0) pv = 0.f;
                        if (sb == 8191) nx = 0.f;
                        const float cv = pv * w0[4 * n + j] + uu[m] * w1[4 * n + j] + nx * w2[4 * n + j] + bb[4 * n + j];
                        av[m][4 * n + j] = cv * __builtin_amdgcn_rcpf(1.0f + __expf(-cv)) * acc[ai][1][m][n][j];
                    }
                }
#pragma unroll
            for (int m = 0; m < 4; ++m) {
                const int i = 16 * m + fr, tok = tok0 + 16 * m;
                if (i >= 1 && i <= 62 && tok < 16384) {
                    u32x4 w; w.x = cvt_pk_bf16(av[m][0], av[m][1]); w.y = cvt_pk_bf16(av[m][2], av[m][3]); w.z = cvt_pk_bf16(av[m][4], av[m][5]); w.w = cvt_pk_bf16(av[m][6], av[m][7]);
                    *(u32x4*)(O + (size_t)tok * 2816 + ch0) = w;
                }
            }
        }
    }
};

struct OrderIn {
    StaticOrder so; int G, c;
    __device__ void init(int G_, int c_) { so.init(16384, 3328, G_, c_); G = G_; c = c_; }
    __device__ bool next(int i, Unit& u) const {
        const long L = (long)i * G + c;
        if (L < so.nwg) return so.next(i, u);
        if (L < so.nwg + 2) { u.pm = 64 + (int)(L - so.nwg); u.pn = 2; return true; }
        return false;
    }
    __device__ __forceinline__ void a_ready(const Unit&) const {}
    __device__ __forceinline__ void done(const Unit&) const {}
};
template <class Epi, class Sched, bool ALIGN_EPI = false, bool SP2 = false>
__device__ __forceinline__ void gemm_phase(PG8_LAS unsigned char* lds, const Gemm g, const Sched& S, const Epi& E) {
    int tid_ = threadIdx.x; asm volatile("" : "+v"(tid_));
    const int tid = tid_, wid = __builtin_amdgcn_readfirstlane(tid >> 6), lane = tid & 63, wr = wid >> 2, wc = wid & 3, fr = lane & 15, fq = lane >> 4;
    const int K = g.K, nt = K / BK;
    unsigned voffA[2], voffB[2];
#pragma unroll
    for (int i = 0; i < 2; ++i) { int R, C; stage_rc(tid * 16 + i * 8192, R, C); const int Rb = Epi::PERM ? ((R & ~31) + perm32(R & 31)) : R;
        voffA[i] = (unsigned)(((R & 63) + g.strip * (R >> 6)) * K + C) * 2u; voffB[i] = (unsigned)(Rb * K + C) * 2u; }
    const size_t kstep = (size_t)(BK * 2);
    const size_t hstep = (size_t)HALF * K * 2;
    const size_t tstep = 2 * hstep;
    const size_t hstepA = (size_t)(2 * g.strip) * K * 2, tstepA = 2 * hstepA;
    const long abias = (g.strip == 64) ? 0 : -(long)K * 2;
    const unsigned ldsw = (unsigned)wid * 1024u;
    const int aoff = lds_byte(wr * 64 + fr, fq * 8), boff = lds_byte(wc * 32 + fr, fq * 8);
#define PG8_SA(b, h) (((b) * 2 + (h)) * HTB)
#define PG8_SB(b, h) ((4 + (b) * 2 + (h)) * HTB)
#define PG8_STAGE(bufoff, gbase, voff) do { _Pragma("unroll") for (int _i = 0; _i < 2; ++_i) \
        __builtin_amdgcn_global_load_lds((const unsigned*)((const char*)(gbase) + (voff)[_i]), (PG8_LAS unsigned*)(lds + (bufoff) + ldsw + _i * 8192), 16, 0, 0); } while (0)
#define PG8_LDA(dst, b, h) do { _Pragma("unroll") for (int m = 0; m < 4; ++m) _Pragma("unroll") for (int k = 0; k < 2; ++k) dst[m][k] = *(const PG8_LAS bf16x8*)(lds + PG8_SA(b, h) + aoff + m * 2048 + k * 1024); } while (0)
#define PG8_LDB(dst, b, h) do { _Pragma("unroll") for (int n = 0; n < 2; ++n) _Pragma("unroll") for (int k = 0; k < 2; ++k) dst[n][k] = *(const PG8_LAS bf16x8*)(lds + PG8_SB(b, h) + boff + n * 2048 + k * 1024); } while (0)
#define PG8_MMA(ai, bj, At, Bt) do { __builtin_amdgcn_s_setprio(1); _Pragma("unroll") for (int m = 0; m < 4; ++m) _Pragma("unroll") for (int n = 0; n < 2; ++n) _Pragma("unroll") for (int k = 0; k < 2; ++k) \
        acc[ai][bj][m][n] = __builtin_amdgcn_mfma_f32_16x16x32_bf16(Bt[n][k], At[m][k], acc[ai][bj][m][n], 0, 0, 0); __builtin_amdgcn_s_setprio(0); } while (0)
#define PG8_WAIT_V(n) asm volatile("s_waitcnt vmcnt(" #n ")" ::: "memory")
#define PG8_WAIT_L(n) asm volatile("s_waitcnt lgkmcnt(" #n ")" ::: "memory")
#define PG8_BAR __builtin_amdgcn_s_barrier()
#define PG8_SCHED __builtin_amdgcn_sched_barrier(0)
    Unit cur, nxt; int ui = 0;
    if (!S.next(0, cur)) return;
    f32x4 acc[2][2][4][2];
#pragma unroll
    for (int a = 0; a < 2; ++a)
#pragma unroll
        for (int b = 0; b < 2; ++b)
#pragma unroll
            for (int m = 0; m < 4; ++m)
#pragma unroll
                for (int n = 0; n < 2; ++n) acc[a][b][m][n] = (f32x4){0.f, 0.f, 0.f, 0.f};
    bf16x8 At[4][2], B0[2][2], B1[2][2];
    const char* cA = (const char*)g.A + (size_t)cur.pm * tstepA + abias; const char* cB = (const char*)g.Bt + (size_t)cur.pn * tstep;
    S.a_ready(cur);
    if constexpr (SP2) {
        PG8_STAGE(PG8_SB(0, 0), cB, voffB); PG8_STAGE(PG8_SB(0, 1), cB + hstep, voffB); PG8_STAGE(PG8_SA(0, 0), cA, voffA); PG8_STAGE(PG8_SA(0, 1), cA + hstepA, voffA);
        if (wr == 1) PG8_BAR;
        PG8_WAIT_V(2); PG8_BAR;
        PG8_STAGE(PG8_SB(1, 0), cB + kstep, voffB); PG8_STAGE(PG8_SA(1, 0), cA + kstep, voffA); PG8_STAGE(PG8_SB(1, 1), cB + hstep + kstep, voffB);
        PG8_WAIT_V(6); PG8_BAR;
    } else {
        PG8_STAGE(PG8_SB(0, 0), cB, voffB); PG8_STAGE(PG8_SA(0, 0), cA, voffA); PG8_STAGE(PG8_SB(0, 1), cB + hstep, voffB); PG8_STAGE(PG8_SA(0, 1), cA + hstepA, voffA);
        if (wr == 1) PG8_BAR;
        PG8_WAIT_V(4); PG8_BAR;
        PG8_STAGE(PG8_SB(1, 0), cB + kstep, voffB); PG8_STAGE(PG8_SA(1, 0), cA + kstep, voffA); PG8_STAGE(PG8_SB(1, 1), cB + hstep + kstep, voffB);
        PG8_WAIT_V(6); PG8_BAR;
    }
    for (;;) {
        const bool has_next = S.next(ui + 1, nxt);
        const char* nA = has_next ? (const char*)g.A + (size_t)nxt.pm * tstepA + abias : cA; const char* nB = has_next ? (const char*)g.Bt + (size_t)nxt.pn * tstep : cB;
        for (int t = 0; t < nt; t += 2) {
            if constexpr (Epi::MID_T > 0) { if (t == Epi::MID_T) E.mid(acc, cur, wr, wc, fr, fq); }
            const bool last = (t == nt - 2);
            const char* a1 = cA + (size_t)(t + 1) * kstep;
            const char* a2 = last ? nA : cA + (size_t)(t + 2) * kstep; const char* b2 = last ? nB : cB + (size_t)(t + 2) * kstep;
            const char* a3 = a2 + kstep; const char* b3 = b2 + kstep;
            if (last && has_next) S.a_ready(nxt);
            if constexpr (SP2) {
            PG8_LDB(B0, 0, 0); PG8_LDB(B1, 0, 1); PG8_SCHED; PG8_LDA(At, 0, 0); PG8_STAGE(PG8_SA(1, 1), a1 + hstepA, voffA);
            PG8_WAIT_V(8); PG8_WAIT_L(0); PG8_BAR; PG8_MMA(0, 0, At, B0); PG8_MMA(0, 1, At, B1); PG8_BAR; PG8_SCHED;
            PG8_LDA(At, 0, 1); PG8_STAGE(PG8_SB(0, 0), b2, voffB); PG8_STAGE(PG8_SB(0, 1), b2 + hstep, voffB); PG8_STAGE(PG8_SA(0, 0), a2, voffA);
            PG8_WAIT_V(8); PG8_WAIT_L(0); PG8_BAR; PG8_MMA(1, 0, At, B0); PG8_MMA(1, 1, At, B1); PG8_BAR; PG8_SCHED;
            PG8_LDB(B0, 1, 0); PG8_LDB(B1, 1, 1); PG8_SCHED; PG8_LDA(At, 1, 0); PG8_STAGE(PG8_SA(0, 1), a2 + hstepA, voffA);
            PG8_WAIT_V(8); PG8_WAIT_L(0); PG8_BAR; PG8_MMA(0, 0, At, B0); PG8_MMA(0, 1, At, B1); PG8_BAR; PG8_SCHED;
            PG8_LDA(At, 1, 1); PG8_STAGE(PG8_SB(1, 0), b3, voffB); PG8_STAGE(PG8_SB(1, 1), b3 + hstep, voffB); PG8_STAGE(PG8_SA(1, 0), a3, voffA);
            PG8_WAIT_V(8); PG8_WAIT_L(0); PG8_BAR; PG8_MMA(1, 0, At, B0); PG8_MMA(1, 1, At, B1); PG8_BAR; PG8_SCHED;
            } else {
            PG8_LDB(B0, 0, 0); PG8_SCHED; PG8_LDA(At, 0, 0); PG8_STAGE(PG8_SA(1, 1), a1 + hstepA, voffA);
            PG8_WAIT_L(8); PG8_BAR; PG8_WAIT_L(0); PG8_MMA(0, 0, At, B0); PG8_BAR; PG8_SCHED;
            PG8_LDB(B1, 0, 1); PG8_STAGE(PG8_SB(0, 0), b2, voffB);
            PG8_BAR; PG8_WAIT_L(0); PG8_MMA(0, 1, At, B1); PG8_BAR;
            PG8_LDA(At, 0, 1); PG8_STAGE(PG8_SA(0, 0), a2, voffA);
            PG8_BAR; PG8_WAIT_L(0); PG8_MMA(1, 0, At, B0); PG8_BAR; PG8_SCHED;
            PG8_STAGE(PG8_SB(0, 1), b2 + hstep, voffB);
            PG8_WAIT_V(6); PG8_BAR; PG8_MMA(1, 1, At, B1); PG8_BAR;
            PG8_LDB(B0, 1, 0); PG8_SCHED; PG8_LDA(At, 1, 0); PG8_STAGE(PG8_SA(0, 1), a2 + hstepA, voffA);
            PG8_WAIT_L(8); PG8_BAR; PG8_WAIT_L(0); PG8_MMA(0, 0, At, B0); PG8_BAR; PG8_SCHED;
            PG8_LDB(B1, 1, 1); PG8_STAGE(PG8_SB(1, 0), b3, voffB);
            PG8_BAR; PG8_WAIT_L(0); PG8_MMA(0, 1, At, B1); PG8_BAR;
            PG8_LDA(At, 1, 1); PG8_STAGE(PG8_SA(1, 0), a3, voffA);
            PG8_BAR; PG8_WAIT_L(0); PG8_MMA(1, 0, At, B0); PG8_BAR; PG8_SCHED;
            PG8_STAGE(PG8_SB(1, 1), b3 + hstep, voffB);
            PG8_WAIT_V(6); PG8_BAR; PG8_MMA(1, 1, At, B1); PG8_BAR;
            }
        }
        if constexpr (ALIGN_EPI) { if (wr == 0) PG8_BAR; }
        if constexpr (!Epi::AFTER_DRAIN) { E(acc, cur, wr, wc, fr, fq); S.done(cur); }
        if (!has_next) break;
#pragma unroll
        for (int a = 0; a < 2; ++a)
#pragma unroll
            for (int b = 0; b < 2; ++b)
#pragma unroll
                for (int m = 0; m < 4; ++m)
#pragma unroll
                    for (int n = 0; n < 2; ++n) acc[a][b][m][n] = (f32x4){0.f, 0.f, 0.f, 0.f};
        cur = nxt; cA = nA; cB = nB; ++ui;
        if constexpr (ALIGN_EPI) { if (wr == 1) PG8_BAR; }
    }
    PG8_WAIT_V(0);
    if constexpr (!ALIGN_EPI) { if (wr == 0) PG8_BAR; }
    PG8_BAR;
    if constexpr (Epi::AFTER_DRAIN) { E.fused(acc, cur, wr, wc, fr, fq, lds, wid, lane); S.done(cur); }
#undef PG8_SA
#undef PG8_SB
#undef PG8_STAGE
#undef PG8_LDA
#undef PG8_LDB
#undef PG8_MMA
#undef PG8_WAIT_V
#undef PG8_WAIT_L
#undef PG8_BAR
#undef PG8_SCHED
}
}
#include <cmath>
#define GAS __attribute__((address_space(1)))
#define LAS __attribute__((address_space(3)))
typedef unsigned short bf16;
typedef unsigned v4u __attribute__((ext_vector_type(4)));
typedef float f32x4 __attribute__((ext_vector_type(4)));
typedef short bf16x8 __attribute__((ext_vector_type(8)));
typedef GAS unsigned gu32;
typedef GAS unsigned long long gu64;
#define RLX_AGENT __ATOMIC_RELAXED, __HIP_MEMORY_SCOPE_AGENT
#define LDS_WAIT() asm volatile("s_waitcnt lgkmcnt(0)" ::: "memory")
#define VM_WAIT() asm volatile("s_waitcnt vmcnt(0)" ::: "memory")
__device__ __forceinline__ unsigned long long rt() { return __builtin_amdgcn_s_memrealtime(); }
__device__ __forceinline__ unsigned f2bf(float f) { unsigned u = __builtin_bit_cast(unsigned, f); return (u + 0x7fffu + ((u >> 16) & 1u)) >> 16; }
__device__ __forceinline__ unsigned pk2(float lo, float hi) { return f2bf(lo) | (f2bf(hi) << 16); }

#define XB_TMO      128
#define XB_XCNT(j)  (256  + 64 * (j))
#define XB_XSUB(j)  (1280 + 64 * (j))
#define XB_XGEN(j)  (2304 + 64 * (j))
#define XB_TOP      3328
#define XB_TOPGEN   3392
#define XCD_BAR_WORDS 3456
#define XB_SPIN_CAP (1u << 18)

__device__ __forceinline__ unsigned xb_ld(unsigned* p)              { return __hip_atomic_load(p, __ATOMIC_RELAXED, __HIP_MEMORY_SCOPE_AGENT); }
__device__ __forceinline__ unsigned xb_add(unsigned* p, unsigned v) { return __hip_atomic_fetch_add(p, v, __ATOMIC_RELAXED, __HIP_MEMORY_SCOPE_AGENT); }
__device__ __forceinline__ unsigned xb_xcc_id() { return (unsigned)__builtin_amdgcn_s_getreg((3 << 11) | 20) & 0xFu; }
#define XB_SPIN(cond, bar) do { unsigned _sp = 0; while (cond) { __builtin_amdgcn_s_sleep(1); \
    if ((++_sp & 255u) == 0u) { if (xb_ld(&(bar)[XB_TMO])) break; if (_sp > XB_SPIN_CAP) { atomicAdd(&(bar)[XB_TMO], 1u); break; } } } } while (0)

struct XcdBarrier {
    unsigned* bar; unsigned x;
    volatile LAS unsigned* st;
};

__device__ __forceinline__ XcdBarrier xcd_barrier_post(unsigned* bar, volatile LAS unsigned* st) {
    XcdBarrier b; b.bar = bar; b.x = xb_xcc_id(); b.st = st;
    if (threadIdx.x == 0) (void)xb_add(&bar[XB_XCNT(b.x)], 1u);
    return b;
}
__device__ __forceinline__ void xcd_barrier_complete(unsigned* bar, unsigned x, unsigned& nloc, unsigned& nx) {
    const unsigned G = gridDim.x * gridDim.y * gridDim.z;
    unsigned sum, cnt, mine, sp = 0u;
    for (;;) {
        sum = 0u; cnt = 0u; mine = 0u;
#pragma unroll
        for (unsigned j = 0; j < 16; ++j) { const unsigned c = xb_ld(&bar[XB_XCNT(j)]); sum += c; cnt += (c > 0u) ? 1u : 0u; mine = (j == x) ? c : mine; }
        if (sum == G) break;
        __builtin_amdgcn_s_sleep(1);
        if ((++sp & 255u) == 0u) { if (xb_ld(&bar[XB_TMO])) break; if (sp > XB_SPIN_CAP) { atomicAdd(&bar[XB_TMO], 1u); break; } }
    }
    nloc = mine > 0u ? mine : 1u; nx = cnt > 0u ? cnt : 1u;
}

__device__ __forceinline__ void xcd_barrier(const XcdBarrier& b) {
    asm volatile("s_waitcnt vmcnt(0)" ::: "memory");
    __syncthreads();
    if (threadIdx.x == 0) {
        unsigned* bar = b.bar;
        __builtin_amdgcn_s_waitcnt(0);
        unsigned nloc = b.st[0], nx = b.st[1];
        if (nloc == 0u) { xcd_barrier_complete(bar, b.x, nloc, nx); b.st[0] = nloc; b.st[1] = nx; }
        const unsigned old = xb_add(&bar[XB_XSUB(b.x)], 1u);
        const unsigned gen = old / nloc;
        if (old + 1u == (gen + 1u) * nloc) {
            __builtin_amdgcn_fence(__ATOMIC_RELEASE, "agent");
            asm volatile("s_waitcnt vmcnt(0)" ::: "memory");
            const unsigned og = xb_add(&bar[XB_TOP], 1u);
            const unsigned tg = og / nx;
            if (og + 1u == (tg + 1u) * nx) xb_add(&bar[XB_TOPGEN], 1u);
            else XB_SPIN(xb_ld(&bar[XB_TOPGEN]) == tg, bar);
            __builtin_amdgcn_fence(__ATOMIC_ACQUIRE, "agent");
            xb_add(&bar[XB_XGEN(b.x)], 1u);
            asm volatile("s_waitcnt vmcnt(0)" ::: "memory");
        } else {
            XB_SPIN(xb_ld(&bar[XB_XGEN(b.x)]) == gen, bar);
            __builtin_amdgcn_fence(__ATOMIC_ACQUIRE, "agent");
            asm volatile("s_waitcnt vmcnt(0)" ::: "memory");
        }
    }
    __syncthreads();
}
__device__ __forceinline__ float sumsq4(pg8::f32x4 v) { return (v[0] * v[0] + v[1] * v[1]) + (v[2] * v[2] + v[3] * v[3]); }
__device__ __forceinline__ void row_sumsq_publish(const pg8::f32x4 (&acc)[2][2][4][2], float* rs, int row0, int fq) {
#pragma unroll
    for (int ai = 0; ai < 2; ++ai)
#pragma unroll
        for (int m = 0; m < 4; ++m) {
            float s = (sumsq4(acc[ai][0][m][0]) + sumsq4(acc[ai][0][m][1])) + (sumsq4(acc[ai][1][m][0]) + sumsq4(acc[ai][1][m][1]));
            s += __shfl_xor(s, 16); s += __shfl_xor(s, 32);
            if (fq == 0) unsafeAtomicAdd(rs + row0 + ai * 128 + m * 16, s);
        }
}
__device__ __forceinline__ void panel_barrier(unsigned* cnt, unsigned target) {
    asm volatile("s_waitcnt vmcnt(0)" ::: "memory");
    __syncthreads();
    if (threadIdx.x == 0) {
        __hip_atomic_fetch_add(cnt, 1u, __ATOMIC_RELAXED, __HIP_MEMORY_SCOPE_AGENT);
        unsigned spins = 0;
        while (__hip_atomic_load(cnt, __ATOMIC_RELAXED, __HIP_MEMORY_SCOPE_AGENT) < target) { __builtin_amdgcn_s_sleep(1); if (++spins > (1u << 22)) break; }
    }
    __syncthreads();
}
struct EpiOutNorm {
    static constexpr bool PERM = true, AFTER_DRAIN = true; static constexpr int MID_T = 0;
    const float* x; pg8::bf16_t* X1; pg8::bf16_t* H; const float* mod; const float* g_post1; const float* g_pre2; float* rs1; float* rs2; unsigned* pcnt;
    __device__ __forceinline__ void fused(pg8::f32x4 (&acc)[2][2][4][2], const pg8::Unit& u, int wr, int wc, int fr, int fq, PG8_LAS unsigned char*, int, int) const {
        using pg8::f32x4;
        const int pm = __builtin_amdgcn_readfirstlane(u.pm), pn = __builtin_amdgcn_readfirstlane(u.pn);
        const int row0 = pm * 256 + wr * 64 + fr, col0 = pn * 256 + wc * 32 + 8 * fq;
        const float* mb = mod + (pm >> 5) * 6144;
        row_sumsq_publish(acc, rs1, row0, fq);
        panel_barrier(pcnt + pm, 4u);
        {
            f32x4 gg[2][2];
#pragma unroll
            for (int bj = 0; bj < 2; ++bj)
#pragma unroll
                for (int n = 0; n < 2; ++n) gg[bj][n] = *(const f32x4*)(g_post1 + col0 + bj * 128 + 4 * n) * *(const f32x4*)(mb + 2048 + col0 + bj * 128 + 4 * n);
#pragma unroll
            for (int ai = 0; ai < 2; ++ai)
#pragma unroll
                for (int m = 0; m < 4; ++m) {
                    const int row = row0 + ai * 128 + m * 16;
                    const float rstd = rsqrtf(__hip_atomic_load(rs1 + row, __ATOMIC_RELAXED, __HIP_MEMORY_SCOPE_AGENT) * (1.f / 1024.f) + 1e-6f);
                    const size_t off = (size_t)row * 1024 + col0;
                    float s2 = 0.f;
#pragma unroll
                    for (int bj = 0; bj < 2; ++bj) {
#pragma unroll
                        for (int n = 0; n < 2; ++n) {
                            const f32x4 xv = __builtin_nontemporal_load((const f32x4*)(x + off + bj * 128 + 4 * n));
                            const f32x4 x1 = xv + gg[bj][n] * (acc[ai][bj][m][n] * rstd);
                            acc[ai][bj][m][n] = x1;
                            s2 += sumsq4(x1);
                        }
                        const f32x4 a0 = acc[ai][bj][m][0], a1 = acc[ai][bj][m][1];
                        pg8::u32x4 w; w.x = pg8::cvt_pk_bf16(a0[0], a0[1]); w.y = pg8::cvt_pk_bf16(a0[2], a0[3]); w.z = pg8::cvt_pk_bf16(a1[0], a1[1]); w.w = pg8::cvt_pk_bf16(a1[2], a1[3]);
                        *(pg8::u32x4*)(X1 + off + bj * 128) = w;
                    }
                    s2 += __shfl_xor(s2, 16); s2 += __shfl_xor(s2, 32);
                    if (fq == 0) unsafeAtomicAdd(rs2 + row, s2);
                    asm volatile("" : "+v"(acc[ai][0][m][0]), "+v"(acc[ai][0][m][1]), "+v"(acc[ai][1][m][0]), "+v"(acc[ai][1][m][1]));
                    if (m & 1) asm volatile("" ::: "memory");
                }
        }
        panel_barrier(pcnt + 64 + pm, 4u);
        {
            f32x4 gp[2][2], sh[2][2];
#pragma unroll
            for (int bj = 0; bj < 2; ++bj)
#pragma unroll
                for (int n = 0; n < 2; ++n) { gp[bj][n] = *(const f32x4*)(g_pre2 + col0 + bj * 128 + 4 * n) * (*(const f32x4*)(mb + 4096 + col0 + bj * 128 + 4 * n) + 1.0f); sh[bj][n] = *(const f32x4*)(mb + 3072 + col0 + bj * 128 + 4 * n); }
#pragma unroll
            for (int ai = 0; ai < 2; ++ai)
#pragma unroll
                for (int m = 0; m < 4; ++m) {
                    const int row = row0 + ai * 128 + m * 16;
                    const float rstd = rsqrtf(__hip_atomic_load(rs2 + row, __ATOMIC_RELAXED, __HIP_MEMORY_SCOPE_AGENT) * (1.f / 1024.f) + 1e-6f);
#pragma unroll
                    for (int bj = 0; bj < 2; ++bj) {
                        const f32x4 h0 = (acc[ai][bj][m][0] * rstd) * gp[bj][0] + sh[bj][0], h1 = (acc[ai][bj][m][1] * rstd) * gp[bj][1] + sh[bj][1];
                        pg8::u32x4 w; w.x = pg8::cvt_pk_bf16(h0[0], h0[1]); w.y = pg8::cvt_pk_bf16(h0[2], h0[3]); w.z = pg8::cvt_pk_bf16(h1[0], h1[1]); w.w = pg8::cvt_pk_bf16(h1[2], h1[3]);
                        *(pg8::u32x4*)(H + (size_t)row * 1024 + col0 + bj * 128) = w;
                    }
                }
        }
    }
};
struct EpiDownNorm {
    static constexpr bool PERM = true, AFTER_DRAIN = true; static constexpr int MID_T = 0;
    const pg8::bf16_t* X1; float* out; const float* mod; const float* g_post2; float* rs3; unsigned* pcnt;
    __device__ __forceinline__ void fused(pg8::f32x4 (&acc)[2][2][4][2], const pg8::Unit& u, int wr, int wc, int fr, int fq, PG8_LAS unsigned char*, int, int) const {
        using pg8::f32x4;
        const int pm = __builtin_amdgcn_readfirstlane(u.pm), pn = __builtin_amdgcn_readfirstlane(u.pn);
        const int row0 = pm * 256 + wr * 64 + fr, col0 = pn * 256 + wc * 32 + 8 * fq;
        const float* mb = mod + (pm >> 5) * 6144;
        row_sumsq_publish(acc, rs3, row0, fq);
        panel_barrier(pcnt + pm, 4u);
        f32x4 gg[2][2];
#pragma unroll
        for (int bj = 0; bj < 2; ++bj)
#pragma unroll
            for (int n = 0; n < 2; ++n) gg[bj][n] = *(const f32x4*)(g_post2 + col0 + bj * 128 + 4 * n) * *(const f32x4*)(mb + 5120 + col0 + bj * 128 + 4 * n);
#pragma unroll
        for (int ai = 0; ai < 2; ++ai)
#pragma unroll
            for (int m = 0; m < 4; ++m) {
                const int row = row0 + ai * 128 + m * 16;
                const float rstd = rsqrtf(__hip_atomic_load(rs3 + row, __ATOMIC_RELAXED, __HIP_MEMORY_SCOPE_AGENT) * (1.f / 1024.f) + 1e-6f);
                const size_t off = (size_t)row * 1024 + col0;
#pragma unroll
                for (int bj = 0; bj < 2; ++bj) {
                    const pg8::u32x4 xw = *(const pg8::u32x4*)(X1 + off + bj * 128);
                    const f32x4 x0 = (f32x4){pg8::bf_lo(xw.x), pg8::bf_hi(xw.x), pg8::bf_lo(xw.y), pg8::bf_hi(xw.y)}, x1v = (f32x4){pg8::bf_lo(xw.z), pg8::bf_hi(xw.z), pg8::bf_lo(xw.w), pg8::bf_hi(xw.w)};
                    __builtin_nontemporal_store(x0 + gg[bj][0] * (acc[ai][bj][m][0] * rstd), (f32x4*)(out + off + bj * 128));
                    __builtin_nontemporal_store(x1v + gg[bj][1] * (acc[ai][bj][m][1] * rstd), (f32x4*)(out + off + bj * 128 + 4));
                }
                if (m & 1) asm volatile("" ::: "memory");
            }
    }
};

constexpr int NWAVES = 8;
constexpr int SEQ = 8192, DM = 1024, MTOK = 16384, MCTX = 512, MALL = MTOK + MCTX, INW = 3328, DFF = 2816;
constexpr float EPS = 1e-6f;
constexpr float QSCALE = 0.125f * 1.4426950408889634f;
constexpr int RING_BYTES = 131072, LDS_BYTES = 147456, LDSCTL_OFF = LDS_BYTES - 512, MISC_OFF = LDSCTL_OFF + 320;

__device__ __forceinline__ float wave_sum(float v) {
#pragma unroll
    for (int o = 1; o < 64; o <<= 1) v += __shfl_xor(v, o);
    return v;
}
__device__ __forceinline__ float silu_f(float x) { return x * __builtin_amdgcn_rcpf(1.0f + __expf(-x)); }

__device__ __forceinline__ void p0_transpose_item(const float* W, int K, int N, bf16* WT, int ldw, int up_perm, int koff, LAS float* scr, int item, int lane) {
    const int nblk = N / 32, kb = item / nblk, nb = item % nblk, k0 = 64 * kb, n0 = 32 * nb;
    int rbase = n0;
    if (up_perm) { const int half = n0 >= DFF ? 1 : 0, jj = n0 - half * DFF; rbase = (jj >> 7) * 256 + half * 128 + (jj & 127); }
#pragma unroll 8
    for (int i = 0; i < 32; ++i) { const int kk = 2 * i + (lane >> 5); scr[kk * 33 + (lane & 31)] = __builtin_nontemporal_load(&W[(size_t)(k0 + kk) * N + n0 + (lane & 31)]); }
    LDS_WAIT(); asm volatile("" ::: "memory");
    const int c = lane & 7;
#pragma unroll
    for (int j = 0; j < 4; ++j) { const int n = (lane >> 3) + 8 * j; const LAS float* s = scr + (8 * c) * 33 + n;
        v4u o; o.x = pk2(s[0 * 33], s[1 * 33]); o.y = pk2(s[2 * 33], s[3 * 33]); o.z = pk2(s[4 * 33], s[5 * 33]); o.w = pk2(s[6 * 33], s[7 * 33]);
        *(v4u*)(WT + (size_t)(rbase + n) * ldw + koff + k0 + 8 * c) = o; }
    LDS_WAIT(); asm volatile("" ::: "memory");
}

struct Args {
    const float *x, *c, *ctx, *c_ctx, *w_mod, *b_mod, *g_pre1, *g_post1, *g_pre2, *g_post2, *w_in, *sink, *w_pa, *w_pf, *w_out, *w_up, *conv_w, *conv_b, *w_down;
    float* out; unsigned char* ws;
};

__device__ __forceinline__ void p0a_adaln(const Args& A, int gw, int NGW, int lane) {
    float* mod = (float*)(A.ws + WS_CTL) + CW_MOD;
    for (int it = gw; it < 96 * 16; it += NGW) {
        const int cc = it % 96, kc = it / 96, col = cc * 64 + lane, k0 = kc * 64;
        const float s0 = silu_f(A.c[k0 + lane]), s1 = silu_f(A.c[1024 + k0 + lane]), s2 = silu_f(A.c_ctx[k0 + lane]);
        float a0 = 0.f, a1 = 0.f, a2 = 0.f;
        const float* wp = A.w_mod + (size_t)k0 * 6144 + col;
#pragma unroll 16
        for (int kk = 0; kk < 64; ++kk) {
            const float w = __builtin_nontemporal_load(wp + (size_t)kk * 6144);
            a0 += __shfl(s0, kk) * w; a1 += __shfl(s1, kk) * w; a2 += __shfl(s2, kk) * w;
        }
        if (kc == 0) { const float b = A.b_mod[col]; a0 += b; a1 += b; a2 += b; }
        unsafeAtomicAdd(mod + col, a0); unsafeAtomicAdd(mod + 6144 + col, a1); unsafeAtomicAdd(mod + 2 * 6144 + col, a2);
    }
}
__device__ __forceinline__ void p0b_win(const Args& A, LAS unsigned char* lds, int gw, int NGW, int wave, int lane) {
    bf16* WinT = (bf16*)(A.ws + WS_WIN);
    LAS float* scr = (LAS float*)(lds + wave * 16384);
    constexpr int I_IN = 16 * (INW / 32);
    for (int it = gw; it < I_IN; it += NGW) p0_transpose_item(A.w_in, 1024, INW, WinT, 1024, 0, 0, scr, it, lane);
}
__device__ __forceinline__ void p0_setup(const Args& A, LAS unsigned char* lds, int widx, int nw, int bidx, int nb, int wave, int lane, int tid) {
    unsigned char* ws = A.ws;
    bf16* WcatT = (bf16*)(ws + WS_WCAT);
    bf16* TA = (bf16*)(ws + WS_TAB); bf16* TB = TA + TA_ELEMS;
    LAS float* TT = (LAS float*)(lds + 8 * 16384 - 1024);
    if (tid < 128) { TT[tid] = cospif((float)tid * (1.0f / 64.0f)); TT[128 + tid] = sinpif((float)tid * (1.0f / 64.0f)); }
    __syncthreads();
    for (int e = widx * 64 + lane; e < TA_ELEMS + TB_ELEMS; e += nw * 64) {
        if (e < TA_ELEMS) {
            const int n = e >> 6, s1 = e & 63, T = n >> 4, c15 = n & 15, t = T >> 1, part = T & 1, k1 = 16 * t + c15, idx = (s1 * k1) & 63;
            const float a = (float)idx * (1.0f / 32.0f);
            TA[e] = (bf16)f2bf(part ? -sinpif(a) : cospif(a));
        } else {
            const int e2 = e - TA_ELEMS, n = e2 >> 8, K = e2 & 255, T = n >> 4, c15 = n & 15, t = T >> 1, pp = T & 1, k2 = 16 * t + c15, part = K >> 7, s2 = K & 127, idx = (s2 * k2) & 127;
            const float a = (float)idx * (1.0f / 64.0f); const float cv = cospif(a), sv = sinpif(a);
            TB[e2] = (bf16)f2bf(part == pp ? cv : (part == 1 ? sv : -sv));
        }
    }
    for (int it = bidx + nb * wave; it < 1024; it += nb * NWAVES) {
        const int g = it & 3, nch = (it >> 2) & 15, cch = it >> 6, n = nch * 64 + lane, c0 = cch * 8;
        float ar[8], ai[8];
#pragma unroll
        for (int cc = 0; cc < 8; ++cc) { ar[cc] = 0.f; ai[cc] = 0.f; }
        const float* wp = A.w_pf + (size_t)(g * 128) * 1024 + n;
#pragma unroll 4
        for (int cp = 0; cp < 128; ++cp) {
            const float w = __builtin_nontemporal_load(wp + (size_t)cp * 1024);
#pragma unroll
            for (int cc = 0; cc < 8; ++cc) { const int idx = ((c0 + cc) * cp) & 127; ar[cc] += TT[idx] * w; ai[cc] += TT[128 + idx] * w; }
        }
        bf16* dst = WcatT + (size_t)n * 1536 + 512 + g * 256 + c0;
        const float sc = 1.f / 1024.f;
        v4u o;
        o.x = pk2(ar[0] * sc, ar[1] * sc); o.y = pk2(ar[2] * sc, ar[3] * sc); o.z = pk2(ar[4] * sc, ar[5] * sc); o.w = pk2(ar[6] * sc, ar[7] * sc);
        *(v4u*)dst = o;
        o.x = pk2(ai[0] * sc, ai[1] * sc); o.y = pk2(ai[2] * sc, ai[3] * sc); o.z = pk2(ai[4] * sc, ai[5] * sc); o.w = pk2(ai[6] * sc, ai[7] * sc);
        *(v4u*)(dst + 128) = o;
    }
}
__device__ __forceinline__ void p0_deferred(const Args& A, LAS unsigned char* lds, int widx, int nw, int bidx, int nb, int wave, int lane, int tid) {
    unsigned char* ws = A.ws;
    bf16* WupT = (bf16*)(ws + WS_WUP); bf16* WdnT = (bf16*)(ws + WS_WDN); bf16* WoutT = (bf16*)(ws + WS_WOUT); bf16* WcatT = (bf16*)(ws + WS_WCAT);
    LAS float* scr = (LAS float*)(lds + wave * 16384);
    constexpr int I_PA = 8 * 32, I_OUT = 16 * 32, I_UP = 16 * (2 * DFF / 32), I_DN = (DFF / 64) * 32;
    for (int it = widx; it < I_PA + I_OUT + I_UP + I_DN; it += nw) {
        int r = it;
        if (r < I_PA) { p0_transpose_item(A.w_pa, 512, 1024, WcatT, 1536, 0, 0, scr, r, lane); continue; } r -= I_PA;
        if (r < I_OUT) { p0_transpose_item(A.w_out, 1024, 1024, WoutT, 1024, 0, 0, scr, r, lane); continue; } r -= I_OUT;
        if (r < I_UP) { p0_transpose_item(A.w_up, 1024, 2 * DFF, WupT, 1024, 1, 0, scr, r, lane); continue; } r -= I_UP;
        p0_transpose_item(A.w_down, DFF, 1024, WdnT, DFF, 0, 0, scr, r, lane);
    }
}
template <int R> __device__ __forceinline__ void p1_group(const float* src, bf16* dst, const f32x4 (&gs)[4], const f32x4 (&sh)[4], int lane) {
    f32x4 v[R][4]; float s[R];
#pragma unroll
    for (int r = 0; r < R; ++r) { const f32x4* xr = (const f32x4*)(src + (size_t)r * DM) + lane; s[r] = 0.f;
#pragma unroll
        for (int j = 0; j < 4; ++j) v[r][j] = __builtin_nontemporal_load(xr + 64 * j); }
#pragma unroll
    for (int r = 0; r < R; ++r)
#pragma unroll
        for (int j = 0; j < 4; ++j) s[r] += (v[r][j].x * v[r][j].x + v[r][j].y * v[r][j].y) + (v[r][j].z * v[r][j].z + v[r][j].w * v[r][j].w);
#pragma unroll
    for (int r = 0; r < R; ++r) {
        const float rs = rsqrtf(wave_sum(s[r]) * (1.f / DM) + EPS);
        unsigned long long* o8 = (unsigned long long*)(dst + (size_t)r * DM) + lane;
#pragma unroll
        for (int j = 0; j < 4; ++j) { const f32x4 h = (v[r][j] * rs) * gs[j] + sh[j]; o8[64 * j] = (unsigned long long)pk2(h.x, h.y) | ((unsigned long long)pk2(h.z, h.w) << 32); }
    }
}
__device__ __forceinline__ void p1_norm(const Args& A, int gw, int NGW, int lane) {
    const float* mod = (const float*)(A.ws + WS_CTL) + CW_MOD;
    bf16* H = (bf16*)(A.ws + WS_H);
    f32x4 g[4], gs[4], sh[4];
#pragma unroll
    for (int j = 0; j < 4; ++j) g[j] = ((const f32x4*)A.g_pre1)[lane + 64 * j];
    const int xg = gw >> 8, wl = gw & 255, mi = xg >> 2;
#pragma unroll
    for (int j = 0; j < 4; ++j) { gs[j] = g[j] * (((const f32x4*)(mod + mi * 6144 + 1024))[lane + 64 * j] + 1.0f); sh[j] = ((const f32x4*)(mod + mi * 6144))[lane + 64 * j]; }
    {
        const int m0 = 2048 * xg + wl * 8;
        p1_group<3>(A.x + (size_t)m0 * DM, H + (size_t)m0 * DM, gs, sh, lane);
        p1_group<3>(A.x + (size_t)(m0 + 3) * DM, H + (size_t)(m0 + 3) * DM, gs, sh, lane);
        p1_group<2>(A.x + (size_t)(m0 + 6) * DM, H + (size_t)(m0 + 6) * DM, gs, sh, lane);
    }
    if ((gw & 3) == 0) {
        const int ci = gw >> 2;
#pragma unroll
        for (int j = 0; j < 4; ++j) { gs[j] = g[j] * (((const f32x4*)(mod + 2 * 6144 + 1024))[lane + 64 * j] + 1.0f); sh[j] = ((const f32x4*)(mod + 2 * 6144))[lane + 64 * j]; }
        p1_group<1>(A.ctx + (size_t)ci * DM, H + (size_t)(MTOK + ci) * DM, gs, sh, lane);
    }
}

__device__ __forceinline__ void attn_unit(const Args& A, LAS unsigned char* lds, int u, int wave, int lane, int tid) {
    const bf16* Q = (const bf16*)(A.ws + WS_Q); const bf16* Kb = (const bf16*)(A.ws + WS_K); const bf16* Vb = (const bf16*)(A.ws + WS_V);
    bf16* O = (bf16*)(A.ws + WS_ACAT);
    const int b = u >> 7, n = (u >> 1) & 63, h = u & 1;
    const int hq = h * 4 + (wave >> 1), qh = wave & 1;
    const int q0 = b * SEQ + n * 128 + qh * 64;
    const int fr = lane & 15, fq = lane >> 4;
    constexpr int KP = 72, VP = 136;
    LAS bf16* Ks = (LAS bf16*)lds; LAS bf16* Vt = (LAS bf16*)(lds + 128 * KP * 2);
    typedef float f32x16 __attribute__((ext_vector_type(16)));
    const int l31 = lane & 31, hh = lane >> 5, dperm = (l31 & ~12) | (((l31 >> 2) & 1) << 3) | (((l31 >> 3) & 1) << 2);
    (void)0;
    bf16x8 bq[2][4];
#pragma unroll
    for (int qt = 0; qt < 2; ++qt)
#pragma unroll
        for (int ks = 0; ks < 4; ++ks) bq[qt][ks] = *(const bf16x8*)(Q + (size_t)(q0 + qt * 32 + l31) * 512 + hq * 64 + ks * 16 + hh * 8);
    f32x16 oacc[2][2];
#pragma unroll
    for (int dt = 0; dt < 2; ++dt)
#pragma unroll
        for (int qt = 0; qt < 2; ++qt)
#pragma unroll
            for (int r = 0; r < 16; ++r) oacc[dt][qt][r] = 0.f;
    float mrun[2], lrun[2];
    const float sk = A.sink[hq] * 1.4426950408889634f;
#pragma unroll
    for (int qt = 0; qt < 2; ++qt) { mrun[qt] = sk; lrun[qt] = 0.f; }
    const int lrow = tid & 127, lseg = tid >> 7;
    v4u pk0, pk1, pv0, pv1;
    int c = (n == 0) ? 1 : 0;
    {
        const int krow0 = (c < 3) ? b * SEQ + (n - 1 + c) * 128 : MTOK + b * 256 + (c - 3) * 128;
        const bf16* kp = Kb + (size_t)(krow0 + lrow) * 128 + h * 64 + lseg * 16; const bf16* vp = Vb + (size_t)(krow0 + lrow) * 128 + h * 64 + lseg * 16;
        pk0 = *(const v4u*)kp; pk1 = *(const v4u*)(kp + 8); pv0 = *(const v4u*)vp; pv1 = *(const v4u*)(vp + 8);
    }
    while (c < 5) {
        __syncthreads();
        {
            *(LAS v4u*)(Ks + lrow * KP + lseg * 16) = pk0; *(LAS v4u*)(Ks + lrow * KP + lseg * 16 + 8) = pk1;
            LAS bf16* vd = Vt + (lseg * 16) * VP + lrow;
            vd[0 * VP] = (bf16)(pv0.x & 0xffff); vd[1 * VP] = (bf16)(pv0.x >> 16); vd[2 * VP] = (bf16)(pv0.y & 0xffff); vd[3 * VP] = (bf16)(pv0.y >> 16);
            vd[4 * VP] = (bf16)(pv0.z & 0xffff); vd[5 * VP] = (bf16)(pv0.z >> 16); vd[6 * VP] = (bf16)(pv0.w & 0xffff); vd[7 * VP] = (bf16)(pv0.w >> 16);
            vd[8 * VP] = (bf16)(pv1.x & 0xffff); vd[9 * VP] = (bf16)(pv1.x >> 16); vd[10 * VP] = (bf16)(pv1.y & 0xffff); vd[11 * VP] = (bf16)(pv1.y >> 16);
            vd[12 * VP] = (bf16)(pv1.z & 0xffff); vd[13 * VP] = (bf16)(pv1.z >> 16); vd[14 * VP] = (bf16)(pv1.w & 0xffff); vd[15 * VP] = (bf16)(pv1.w >> 16);
        }
        __syncthreads();
        int cn = c + 1; if (cn == 2 && n == 63) cn = 3;
        if (cn < 5) {
            const int krow0 = (cn < 3) ? b * SEQ + (n - 1 + cn) * 128 : MTOK + b * 256 + (cn - 3) * 128;
            const bf16* kp = Kb + (size_t)(krow0 + lrow) * 128 + h * 64 + lseg * 16; const bf16* vp = Vb + (size_t)(krow0 + lrow) * 128 + h * 64 + lseg * 16;
            pk0 = *(const v4u*)kp; pk1 = *(const v4u*)(kp + 8); pv0 = *(const v4u*)vp; pv1 = *(const v4u*)(vp + 8);
        }
        for (int sc = 0; sc < 4; ++sc) {
            if ((c == 0 && sc * 32 + 31 < qh * 64) || (c == 2 && sc * 32 > qh * 64 + 63)) continue;
            const bool mixed = (c == 0 && sc * 32 < qh * 64 + 63) || (c == 2 && sc * 32 + 31 > qh * 64);
            f32x16 s[2];
#pragma unroll
            for (int qt = 0; qt < 2; ++qt)
#pragma unroll
                for (int r = 0; r < 16; ++r) s[qt][r] = -mrun[qt];
#pragma unroll
            for (int ks = 0; ks < 4; ++ks) {
                const bf16x8 ka = *(const LAS bf16x8*)(Ks + (sc * 32 + l31) * KP + ks * 16 + hh * 8);
#pragma unroll
                for (int qt = 0; qt < 2; ++qt) s[qt] = __builtin_amdgcn_mfma_f32_32x32x16_bf16(ka, bq[qt][ks], s[qt], 0, 0, 0);
            }
            if (mixed) {
#pragma unroll
                for (int qt = 0; qt < 2; ++qt) {
                    const int qidx = qh * 64 + qt * 32 + l31;
#pragma unroll
                    for (int r = 0; r < 16; ++r) { const int kidx = sc * 32 + (r & 3) + 8 * (r >> 2) + 4 * hh; const bool ok = (c == 0) ? (kidx >= qidx) : (kidx <= qidx); if (!ok) s[qt][r] = -INFINITY; }
                }
            }
            bf16x8 pf[2][2];
#pragma unroll
            for (int qt = 0; qt < 2; ++qt) {
                float mx = s[qt][0];
#pragma unroll
                for (int r = 1; r < 16; ++r) mx = fmaxf(mx, s[qt][r]);
                mx = fmaxf(mx, __shfl_xor(mx, 32));
                const bool grow = mx > 0.f;
                if (__builtin_amdgcn_ballot_w64(grow) != 0ull) {
                    const float dlt = fmaxf(mx, 0.f), alpha = __builtin_amdgcn_exp2f(-dlt);
                    mrun[qt] += dlt; lrun[qt] *= alpha;
                    s[qt] = s[qt] - dlt;
#pragma unroll
                    for (int dt = 0; dt < 2; ++dt) oacc[dt][qt] = oacc[dt][qt] * alpha;
                }
                float p[16]; float ps = 0.f;
#pragma unroll
                for (int r = 0; r < 16; ++r) { p[r] = __builtin_amdgcn_exp2f(s[qt][r]); ps += p[r]; }
                lrun[qt] += ps;
#pragma unroll
                for (int ss = 0; ss < 2; ++ss) {
                    v4u pw; pw.x = pg8::cvt_pk_bf16(p[8 * ss + 0], p[8 * ss + 1]); pw.y = pg8::cvt_pk_bf16(p[8 * ss + 2], p[8 * ss + 3]); pw.z = pg8::cvt_pk_bf16(p[8 * ss + 4], p[8 * ss + 5]); pw.w = pg8::cvt_pk_bf16(p[8 * ss + 6], p[8 * ss + 7]);
                    pf[qt][ss] = __builtin_bit_cast(bf16x8, pw);
                }
            }
#pragma unroll
            for (int dt = 0; dt < 2; ++dt)
#pragma unroll
                for (int ss = 0; ss < 2; ++ss) {
                    const LAS bf16* vrow = Vt + (dt * 32 + dperm) * VP + sc * 32 + 16 * ss + 4 * hh;
                    const pg8::u32x2 vlo = *(const LAS pg8::u32x2*)vrow, vhi = *(const LAS pg8::u32x2*)(vrow + 8);
                    const bf16x8 vfrag = __builtin_bit_cast(bf16x8, (v4u){vlo.x, vlo.y, vhi.x, vhi.y});
#pragma unroll
                    for (int qt = 0; qt < 2; ++qt) oacc[dt][qt] = __builtin_amdgcn_mfma_f32_32x32x16_bf16(vfrag, pf[qt][ss], oacc[dt][qt], 0, 0, 0);
                }
        }
        c = cn;
    }
#pragma unroll
    for (int qt = 0; qt < 2; ++qt) {
        float l = lrun[qt]; l += __shfl_xor(l, 32);
        l += __builtin_amdgcn_exp2f(sk - mrun[qt]);
        const float inv = 1.0f / l;
        bf16* orow = O + (size_t)(q0 + qt * 32 + l31) * 1536 + hq * 64 + 8 * hh;
#pragma unroll
        for (int dt = 0; dt < 2; ++dt)
#pragma unroll
            for (int j2 = 0; j2 < 2; ++j2) {
                v4u w;
                w.x = pg8::cvt_pk_bf16(oacc[dt][qt][8 * j2 + 0] * inv, oacc[dt][qt][8 * j2 + 1] * inv); w.y = pg8::cvt_pk_bf16(oacc[dt][qt][8 * j2 + 2] * inv, oacc[dt][qt][8 * j2 + 3] * inv);
                w.z = pg8::cvt_pk_bf16(oacc[dt][qt][8 * j2 + 4] * inv, oacc[dt][qt][8 * j2 + 5] * inv); w.w = pg8::cvt_pk_bf16(oacc[dt][qt][8 * j2 + 6] * inv, oacc[dt][qt][8 * j2 + 7] * inv);
                *(v4u*)(orow + dt * 32 + 16 * j2) = w;
            }
    }
}
__device__ __forceinline__ void ffta_item(const Args& A, LAS unsigned char* lds, int item, int wave, int lane, int tid) {
    const bf16* F = (const bf16*)(A.ws + WS_F); bf16* Y1 = (bf16*)(A.ws + WS_Y1);
    const bf16* TA = (const bf16*)(A.ws + WS_TAB);
    const int b = item >> 7, s2 = item & 127, fr = lane & 15, fq = lane >> 4;
    constexpr int XP = 514;
    LAS bf16* X = (LAS bf16*)lds;
    __syncthreads();
    for (int i = tid; i < 64 * 64; i += 512) {
        const int s1 = i >> 6, pc = i & 63;
        const v4u v = *(const v4u*)(F + (size_t)(b * SEQ + 128 * s1 + s2) * 512 + pc * 8);
        LAS unsigned* d = (LAS unsigned*)(X + s1 * XP + pc * 8);
        d[0] = v.x; d[1] = v.y; d[2] = v.z; d[3] = v.w;
    }
    __syncthreads();
    bf16x8 af[4][2];
#pragma unroll
    for (int mt = 0; mt < 4; ++mt)
#pragma unroll
        for (int ks = 0; ks < 2; ++ks) {
            const LAS bf16* p = X + (32 * ks + 8 * fq) * XP + wave * 64 + mt * 16 + fr;
            bf16x8 av;
#pragma unroll
            for (int j = 0; j < 8; ++j) av[j] = (short)p[j * XP];
            af[mt][ks] = av;
        }
#pragma unroll 1
    for (int nh = 0; nh < 2; ++nh) {
        f32x4 acc[4][4];
#pragma unroll
        for (int nt = 0; nt < 4; ++nt) {
            const bf16x8 b0 = *(const bf16x8*)(TA + (size_t)((nh * 4 + nt) * 16 + fr) * 64 + fq * 8), b1 = *(const bf16x8*)(TA + (size_t)((nh * 4 + nt) * 16 + fr) * 64 + 32 + fq * 8);
#pragma unroll
            for (int mt = 0; mt < 4; ++mt) {
                f32x4 z = (f32x4){0.f, 0.f, 0.f, 0.f};
                z = __builtin_amdgcn_mfma_f32_16x16x32_bf16(af[mt][0], b0, z, 0, 0, 0);
                acc[mt][nt] = __builtin_amdgcn_mfma_f32_16x16x32_bf16(af[mt][1], b1, z, 0, 0, 0);
            }
        }
#pragma unroll
        for (int tt = 0; tt < 2; ++tt) {
            const int k1 = 16 * (2 * nh + tt) + fr;
            const float a = (float)((s2 * k1) & 8191) * (1.0f / 4096.0f);
            const float cth = cospif(a), sth = sinpif(a);
            bf16* dst = Y1 + ((size_t)((b * 64 + k1) * 128 + s2)) * 1024 + wave * 64 + 4 * fq;
#pragma unroll
            for (int mt = 0; mt < 4; ++mt) {
                const f32x4 yr = acc[mt][2 * tt], yi = acc[mt][2 * tt + 1];
                const f32x4 zr = yr * cth + yi * sth, zi = yi * cth - yr * sth;
                pg8::u32x2 w; w.x = pg8::cvt_pk_bf16(zr[0], zr[1]); w.y = pg8::cvt_pk_bf16(zr[2], zr[3]);
                *(pg8::u32x2*)(dst + mt * 16) = w;
                w.x = pg8::cvt_pk_bf16(zi[0], zi[1]); w.y = pg8::cvt_pk_bf16(zi[2], zi[3]);
                *(pg8::u32x2*)(dst + 512 + mt * 16) = w;
            }
        }
    }
}

typedef short s16x4 __attribute__((ext_vector_type(4)));
__device__ __forceinline__ void fftb_phase(const Args& A, LAS unsigned char* lds, int bx, int G, int wave, int lane, int tid) {
    const bf16* Y1 = (const bf16*)(A.ws + WS_Y1); bf16* P = (bf16*)(A.ws + WS_ACAT);
    const bf16* TB = (const bf16*)(A.ws + WS_TAB) + TA_ELEMS;
    const int fr = lane & 15, fq = lane >> 4, wm = wave >> 2, wn = wave & 3;
    constexpr int PB = 272, IMG = 256 * PB;
    bf16x8 bfr[8][4];
#pragma unroll
    for (int ks = 0; ks < 8; ++ks)
#pragma unroll
        for (int nt = 0; nt < 4; ++nt) bfr[ks][nt] = *(const bf16x8*)(TB + (size_t)((wn * 4 + nt) * 16 + fr) * 256 + ks * 32 + fq * 8);
    for (int it0 = bx; it0 < 512; it0 += 2 * G) {
        const int nimg = (it0 + G < 512) ? 2 : 1;
        __syncthreads();
        for (int img = 0; img < nimg; ++img) {
            const int it = it0 + img * G, g = it & 3, k1 = (it >> 2) & 63, b = it >> 8;
            const bf16* src = Y1 + ((size_t)((b * 64 + k1) * 128)) * 1024 + g * 128 + (tid & 15) * 8;
            LAS unsigned char* dstl = lds + img * IMG + (tid >> 4) * PB + (tid & 15) * 16;
#pragma unroll 1
            for (int jb = 0; jb < 2; ++jb) {
                v4u v[4];
#pragma unroll
                for (int jj = 0; jj < 4; ++jj) { const int K = (tid >> 4) + 32 * (4 * jb + jj), part = K >> 7, s2 = K & 127; v[jj] = *(const v4u*)(src + (size_t)s2 * 1024 + part * 512); }
#pragma unroll
                for (int jj = 0; jj < 4; ++jj) *(LAS v4u*)(dstl + 32 * (4 * jb + jj) * PB) = v[jj];
            }
        }
        __syncthreads();
        for (int img = 0; img < nimg; ++img) {
            const int it = it0 + img * G, g = it & 3, k1 = (it >> 2) & 63, b = it >> 8;
            f32x4 acc[4][4];
#pragma unroll
            for (int mt = 0; mt < 4; ++mt)
#pragma unroll
                for (int nt = 0; nt < 4; ++nt) acc[mt][nt] = (f32x4){0.f, 0.f, 0.f, 0.f};
            const LAS unsigned char* xb = lds + img * IMG + (8 * fq + (fr >> 2)) * PB + 16 * (fr & 3) + wm * 128;
#pragma unroll
            for (int ks = 0; ks < 8; ++ks) {
                bf16x8 af[4];
#pragma unroll
                for (int mt = 0; mt < 4; ++mt) {
                    const s16x4 lo = __builtin_amdgcn_ds_read_tr16_b64_v4i16((LAS s16x4*)(xb + (32 * ks) * PB + 64 * (mt >> 1) + 8 * (mt & 1)));
                    const s16x4 hi = __builtin_amdgcn_ds_read_tr16_b64_v4i16((LAS s16x4*)(xb + (32 * ks + 4) * PB + 64 * (mt >> 1) + 8 * (mt & 1)));
                    af[mt] = __builtin_shufflevector(lo, hi, 0, 1, 2, 3, 4, 5, 6, 7);
                }
#pragma unroll
                for (int mt = 0; mt < 4; ++mt)
#pragma unroll
                    for (int nt = 0; nt < 4; ++nt) acc[mt][nt] = __builtin_amdgcn_mfma_f32_16x16x32_bf16(af[mt], bfr[ks][nt], acc[mt][nt], 0, 0, 0);
            }
#pragma unroll
            for (int nt = 0; nt < 4; ++nt) {
                const int T = 4 * wn + nt, t = T >> 1, pp = T & 1, k2 = 16 * t + fr, sp = k1 + 64 * k2;
                bf16* dst = P + (size_t)(b * SEQ + sp) * 1536 + 512 + g * 256 + pp * 128 + wm * 64 + 8 * fq;
#pragma unroll
                for (int mp = 0; mp < 2; ++mp) {
                    const f32x4 z0 = acc[2 * mp][nt], z1 = acc[2 * mp + 1][nt];
                    v4u w; w.x = pg8::cvt_pk_bf16(z0[0], z0[1]); w.y = pg8::cvt_pk_bf16(z0[2], z0[3]); w.z = pg8::cvt_pk_bf16(z1[0], z1[1]); w.w = pg8::cvt_pk_bf16(z1[2], z1[3]);
                    *(v4u*)(dst + mp * 32) = w;
                }
            }
        }
    }
}

__global__ void __launch_bounds__(NWAVES * 64, 2) fwd_megakernel(Args A) {
    extern __shared__ __attribute__((aligned(16))) unsigned char lds_raw[];
    LAS unsigned char* lds = (LAS unsigned char*)lds_raw;
    volatile LAS unsigned* MISC = (volatile LAS unsigned*)(lds + MISC_OFF);
    const int tid = threadIdx.x;
#define FRESH() int tid_ = threadIdx.x; asm volatile("" : "+v"(tid_)); const int lane_ = tid_ & 63, wave_ = __builtin_amdgcn_readfirstlane(tid_ >> 6), gw_ = vcu * NWAVES + wave_
    const int G = gridDim.x, bx = blockIdx.x, vcu = (G % 8 == 0) ? (bx % 8) * (G / 8) + bx / 8 : bx;
    const int NGW = G * NWAVES;
    unsigned* ctl = (unsigned*)(A.ws + WS_CTL);
    for (int u = tid; u < (LDS_BYTES - LDSCTL_OFF) / 4; u += NWAVES * 64) ((LAS unsigned*)(lds + LDSCTL_OFF))[u] = 0u;
    __syncthreads();
    XcdBarrier bar = xcd_barrier_post(ctl + CW_BAR, MISC + 8);
    unsigned char* ws = A.ws;

    { FRESH(); p0a_adaln(A, gw_, NGW, lane_); }
    xcd_barrier(bar);
#ifdef PROBE_C2
    xcd_barrier(bar);
#endif
    { FRESH(); p0_setup(A, lds, gw_, NGW, vcu, G, wave_, lane_, tid_); p0b_win(A, lds, gw_, NGW, wave_, lane_); p1_norm(A, gw_, NGW, lane_); }
    xcd_barrier(bar);
    {
        pg8::Gemm g{(const pg8::bf16_t*)(ws + WS_H), (const pg8::bf16_t*)(ws + WS_WIN), MALL, INW, 1024, 64};
        pg8::OrderIn S; S.init(G, bx);
        pg8::EpiIn E{(pg8::bf16_t*)ws, QSCALE, ctl + CW_FCNT};
        pg8::gemm_phase<pg8::EpiIn, pg8::OrderIn, true, true>(lds, g, S, E);
#ifdef PROBE_G2
        __syncthreads(); pg8::gemm_phase<pg8::EpiIn, pg8::OrderIn, true, true>(lds, g, S, E);
#endif
    }
    {
        const int nu = 64 * 13 + 2, rounds = (nu + G - 1) / G, extra = nu - (rounds - 1) * G;
        FRESH();
        const int part0 = (extra >= G) ? 0 : extra, nbp = G - part0;
        if (bx >= part0) {
            p0_deferred(A, lds, (bx - part0) * NWAVES + wave_, nbp * NWAVES, bx - part0, nbp, wave_, lane_, tid_);
            if (tid_ == 0) {
                unsigned spins = 0;
                while (__hip_atomic_load(ctl + CW_FCNT, __ATOMIC_RELAXED, __HIP_MEMORY_SCOPE_AGENT) < 128u * 8u) { __builtin_amdgcn_s_sleep(4); if (++spins > (1u << 20)) break; }
                __builtin_amdgcn_fence(__ATOMIC_ACQUIRE, "agent");
                asm volatile("s_waitcnt vmcnt(0)" ::: "memory");
            }
            __syncthreads();
            for (int it = bx - part0; it < 256; it += nbp) ffta_item(A, lds, it, wave_, lane_, tid_);
        }
    }
    xcd_barrier(bar);
#ifdef PROBE_C2
    xcd_barrier(bar);
#endif
    { FRESH(); for (int u = vcu; u < 256; u += G) attn_unit(A, lds, u, wave_, lane_, tid_); }
    { FRESH(); fftb_phase(A, lds, vcu, G, wave_, lane_, tid_); }
    xcd_barrier(bar);
    {
        pg8::Gemm g{(const pg8::bf16_t*)(ws + WS_ACAT), (const pg8::bf16_t*)(ws + WS_WCAT), MTOK, 1024, 1536, 64};
        pg8::StaticOrder S; S.init(MTOK, 1024, G, bx);
        pg8::EpiMerge E{(const pg8::bf16_t*)(ws + WS_GA), (const pg8::bf16_t*)(ws + WS_GF), (pg8::bf16_t*)(ws + WS_MB)};
        pg8::gemm_phase<pg8::EpiMerge, pg8::StaticOrder, true, true>(lds, g, S, E);
#ifdef PROBE_G5
        __syncthreads(); pg8::gemm_phase<pg8::EpiMerge, pg8::StaticOrder, true, true>(lds, g, S, E);
#endif
    }
    xcd_barrier(bar);
    {
        float* ctlf = (float*)(ws + WS_CTL);
        pg8::Gemm g{(const pg8::bf16_t*)(ws + WS_MB), (const pg8::bf16_t*)(ws + WS_WOUT), MTOK, 1024, 1024, 64};
        pg8::StaticOrder S; S.init(MTOK, 1024, G, bx);
        EpiOutNorm E{A.x, (pg8::bf16_t*)(ws + WS_YB), (pg8::bf16_t*)(ws + WS_H), ctlf + CW_MOD, A.g_post1, A.g_pre2, ctlf + CW_RS1, ctlf + CW_RS2, ctl + CW_PCNT};
        pg8::gemm_phase<EpiOutNorm, pg8::StaticOrder, false, true>(lds, g, S, E);
    }
    xcd_barrier(bar);
    {
        pg8::Gemm g{(const pg8::bf16_t*)(ws + WS_H), (const pg8::bf16_t*)(ws + WS_WUP), 67 * 256, 2 * DFF, 1024, 62};
        pg8::StaticOrder S; S.init(67 * 256, 2 * DFF, G, bx);
        pg8::EpiUp E{A.conv_w, A.conv_b, (pg8::bf16_t*)(ws + WS_G)};
        pg8::gemm_phase<pg8::EpiUp, pg8::StaticOrder, true, true>(lds, g, S, E);
#ifdef PROBE_G8
        __syncthreads(); pg8::gemm_phase<pg8::EpiUp, pg8::StaticOrder, true, true>(lds, g, S, E);
#endif
    }
    xcd_barrier(bar);
    {
        float* ctlf = (float*)(ws + WS_CTL);
        pg8::Gemm g{(const pg8::bf16_t*)(ws + WS_G), (const pg8::bf16_t*)(ws + WS_WDN), MTOK, 1024, DFF, 64};
        pg8::StaticOrder S; S.init(MTOK, 1024, G, bx);
        EpiDownNorm E{(const pg8::bf16_t*)(ws + WS_YB), A.out, ctlf + CW_MOD, A.g_post2, ctlf + CW_RS3, ctl + CW_PCNT + 128};
        pg8::gemm_phase<EpiDownNorm, pg8::StaticOrder, false, true>(lds, g, S, E);
    }
}

extern "C" void kernel_launch(void* const* d_in, const int* in_sizes, int n_in, void* d_out, int out_size, void* d_ws, size_t ws_size, hipStream_t stream) {
    static int grid = 0;
    if (grid == 0) {
        if (n_in != 19 || ws_size < WS_END) { fprintf(stderr, "kernel_launch: unexpected inputs (n_in %d, ws %zu)\n", n_in, ws_size); grid = -1; return; }
        int dev = 0, cus = 0, per_cu = 0;
        if (hipGetDevice(&dev) != hipSuccess || hipDeviceGetAttribute(&cus, hipDeviceAttributeMultiprocessorCount, dev) != hipSuccess) { grid = -1; return; }
        if (hipFuncSetAttribute((const void*)fwd_megakernel, hipFuncAttributeMaxDynamicSharedMemorySize, LDS_BYTES) != hipSuccess) { fprintf(stderr, "kernel_launch: hipFuncSetAttribute failed\n"); grid = -1; return; }
        if (hipOccupancyMaxActiveBlocksPerMultiprocessor(&per_cu, (const void*)fwd_megakernel, NWAVES * 64, LDS_BYTES) != hipSuccess || per_cu < 1) { fprintf(stderr, "kernel_launch: occupancy query reports %d\n", per_cu); }
        (void)hipGetLastError();
        grid = cus;
    }
    if (grid < 0) return;
    if (hipMemsetAsync((char*)d_ws + WS_CTL, 0, CTL_ZERO_BYTES, stream) != hipSuccess) return;
    Args a{};
    const float** ap = (const float**)&a;
    for (int i = 0; i < 19; ++i) ap[i] = (const float*)d_in[i];
    a.out = (float*)d_out; a.ws = (unsigned char*)d_ws;
    hipLaunchKernelGGL(fwd_megakernel, dim3(grid), dim3(NWAVES * 64), LDS_BYTES, stream, a);
}
```

```cpp
#include <cstddef>
constexpr size_t MiB = 1u << 20;
constexpr size_t WS_CTL = 0, CTL_ZERO_BYTES = 1 * MiB;
constexpr size_t WS_WIN = 1 * MiB, WS_WUP = 8 * MiB, WS_WDN = 19 * MiB, WS_WCAT = 25 * MiB, WS_WOUT = 28 * MiB, WS_TAB = 30 * MiB;
constexpr size_t WS_H = 31 * MiB;
constexpr size_t WS_Q = 65 * MiB, WS_K = 81 * MiB, WS_V = 86 * MiB, WS_F = 91 * MiB, WS_Y1 = 107 * MiB, WS_ACAT = 139 * MiB, WS_GA = 187 * MiB, WS_GF = 219 * MiB;
constexpr size_t WS_MB = 65 * MiB;
constexpr size_t WS_YB = 107 * MiB;
constexpr size_t WS_U = 65 * MiB, WS_G = 153 * MiB;
constexpr size_t WS_ZB = 65 * MiB;
constexpr size_t WS_END = 251 * MiB;
constexpr int CW_BAR = 4096;
constexpr int CW_MOD = 32768;
constexpr int TA_ELEMS = 128 * 64, TB_ELEMS = 256 * 256;
constexpr int CW_PCNT = 12288;
constexpr int CW_FCNT = 8192;
constexpr int CW_RS1 = 65536, CW_RS2 = 81920, CW_RS3 = 98304;
#include <hip/hip_runtime.h>
#include <cstdio>
#include <cstdint>
namespace pg8 {
#define PG8_LAS __attribute__((address_space(3)))
typedef unsigned short bf16_t;
typedef short bf16x8 __attribute__((ext_vector_type(8)));
typedef float f32x4 __attribute__((ext_vector_type(4)));
typedef unsigned u32x4 __attribute__((ext_vector_type(4)));
constexpr int BM = 256, BK = 64, HALF = 128, HTB = HALF * BK * 2  , STAGE_BYTES = 8 * HTB, NXCD = 8, WGM = 8;

__host__ __device__ __forceinline__ int lds_byte(int r, int c) { const int st = (r >> 4) * 2 + (c >> 5), rr = r & 15, cc = c & 31, ob = rr * 64 + cc * 2; return st * 1024 + (ob ^ (((ob >> 9) & 1) << 5)); }
__host__ __device__ __forceinline__ void stage_rc(int b, int& R, int& C) { const int st = b / 1024, sb = b % 1024, swz = sb ^ (((sb >> 9) & 1) << 5); R = (st >> 1) * 16 + swz / 64; C = (st & 1) * 32 + (swz % 64) / 2; }
__host__ __device__ __forceinline__ int perm32(int rho) { const int n = rho >> 4, i = rho & 15; return 8 * (i >> 2) + 4 * n + (i & 3); }

struct Unit { int pm, pn; };
struct Gemm { const bf16_t* A; const bf16_t* Bt; int M, N, K; int strip; };

struct StaticOrder {
    int nM, nN, nwg, G, c;
    __host__ __device__ void init(int M, int N, int G_, int c_) { nM = M / BM; nN = N / BM; nwg = nM * nN; G = G_; c = c_; }
    __host__ __device__ bool next(int i, Unit& u) const {
        const long L = (long)i * G + c; if (L >= nwg) return false;
        int wgid = (int)L; { const int q = nwg / NXCD, r = nwg % NXCD, xcd = wgid % NXCD, off = wgid / NXCD; wgid = (xcd < r ? xcd * (q + 1) : r * (q + 1) + (xcd - r) * q) + off; }
        const int nig = WGM * nN, gid = wgid / nig, fm = gid * WGM, gsz = (nM - fm) < WGM ? (nM - fm) : WGM;
        u.pm = fm + ((wgid % nig) % gsz); u.pn = (wgid % nig) / gsz; return true;
    }
    __device__ __forceinline__ void a_ready(const Unit&) const {}
    __device__ __forceinline__ void done(const Unit&) const {}
};

typedef __bf16 bf16x2n_t __attribute__((ext_vector_type(2)));
typedef float f32x2n_t __attribute__((ext_vector_type(2)));
__device__ __forceinline__ unsigned cvt_pk_bf16(float lo, float hi) { const f32x2n_t v = {lo, hi}; const bf16x2n_t r = __builtin_convertvector(v, bf16x2n_t); return __builtin_bit_cast(unsigned, r); }
typedef float f32x2 __attribute__((ext_vector_type(2)));
typedef unsigned u32x2 __attribute__((ext_vector_type(2)));
__device__ __forceinline__ float bf_lo(unsigned w) { return __uint_as_float(w << 16); }
__device__ __forceinline__ float bf_hi(unsigned w) { return __uint_as_float(w & 0xffff0000u); }
__device__ __forceinline__ float sigmoid_f(float x) { return __builtin_amdgcn_rcpf(1.0f + __expf(-x)); }

struct EpiBf16 {
    static constexpr bool PERM = true, AFTER_DRAIN = false; static constexpr int MID_T = 0;
    bf16_t* O; int ldc; int split_cols; size_t split_stride;
    __device__ __forceinline__ void operator()(const f32x4 (&acc)[2][2][4][2], const Unit& u, int wr, int wc, int fr, int fq) const {
        const int row0 = u.pm * BM + wr * 64 + fr; int colt = u.pn * BM; bf16_t* base = O;
        if (split_cols) { const int t = colt / split_cols; base += (size_t)t * split_stride; colt -= t * split_cols; }
        const int col0 = colt + wc * 32 + 8 * fq;
#pragma unroll
        for (int ai = 0; ai < 2; ++ai)
#pragma unroll
            for (int m = 0; m < 4; ++m) { bf16_t* rowp = base + (size_t)(row0 + ai * HALF + m * 16) * ldc + col0;
#pragma unroll
                for (int bj = 0; bj < 2; ++bj) { const f32x4 v0 = acc[ai][bj][m][0], v1 = acc[ai][bj][m][1];
                    u32x4 w; w.x = cvt_pk_bf16(v0[0], v0[1]); w.y = cvt_pk_bf16(v0[2], v0[3]); w.z = cvt_pk_bf16(v1[0], v1[1]); w.w = cvt_pk_bf16(v1[2], v1[3]);
                    *(u32x4*)(rowp + bj * HALF) = w; } }
    }
};

struct EpiIn {
    static constexpr bool PERM = false, AFTER_DRAIN = false; static constexpr int MID_T = 0;
    bf16_t* base0; float qscale; unsigned* fcnt;
    static constexpr unsigned oQ = WS_Q / 2, oK = WS_K / 2, oV = WS_V / 2, oF = WS_F / 2, oGA = WS_GA / 2, oGF = WS_GF / 2;
    __device__ __forceinline__ void operator()(const f32x4 (&acc)[2][2][4][2], const Unit& u, int wr, int wc, int fr, int fq) const {
        const int pn = u.pn;
        const int row0 = u.pm * BM + wr * 64 + fr;
        if (pn <= 2) {
            float invf[4];
#pragma unroll
            for (int j = 0; j < 4; ++j) invf[j] = exp2f(-(float)(4 * fq + j) * 0.830482023f) * 0.15915494309f;
#pragma unroll
            for (int ai = 0; ai < 2; ++ai)
#pragma unroll
                for (int m = 0; m < 4; ++m) {
                    const int row = row0 + ai * HALF + m * 16;
                    const int t = row & 8191; const float pos = (float)((wc & 1) ? (t & 63) : (t >> 6));
                    float cs[4], sn[4];
#pragma unroll
                    for (int j = 0; j < 4; ++j) { const float rev = pos * invf[j]; const float fr_ = rev - floorf(rev); cs[j] = __builtin_amdgcn_cosf(fr_); sn[j] = __builtin_amdgcn_sinf(fr_); }
#pragma unroll
                    for (int bj = 0; bj < 2; ++bj) {
                        f32x4 v0 = acc[ai][bj][m][0], v1 = acc[ai][bj][m][1];
                        const bool rope = (pn < 2) || (bj == 0 && row < 16384);
                        if (rope) {
#pragma unroll
                            for (int j = 0; j < 4; ++j) { const float a = v0[j], b = v1[j]; v0[j] = a * cs[j] - b * sn[j]; v1[j] = b * cs[j] + a * sn[j]; }
                        }
                        unsigned doff;
                        if (pn < 2) { v0 = v0 * qscale; v1 = v1 * qscale; doff = oQ + (unsigned)row * 512u + pn * 256 + bj * HALF + wc * 32 + 4 * fq; }
                        else doff = (bj == 0 ? oK : oV) + (unsigned)row * 128u + wc * 32 + 4 * fq;
                        bf16_t* dst = base0 + doff;
                        u32x2 w0, w1; w0.x = cvt_pk_bf16(v0[0], v0[1]); w0.y = cvt_pk_bf16(v0[2], v0[3]); w1.x = cvt_pk_bf16(v1[0], v1[1]); w1.y = cvt_pk_bf16(v1[2], v1[3]);
                        *(u32x2*)dst = w0; *(u32x2*)(dst + 16) = w1;
                    }
                }
        } else {
            const bool isf = pn <= 4;
            unsigned boff; int ldc, colt;
            if (isf) { boff = oF; ldc = 512; colt = (pn - 3) * 256; }
            else if (pn <= 8) { boff = oGA; ldc = 1024; colt = (pn - 5) * 256; }
            else { boff = oGF; ldc = 1024; colt = (pn - 9) * 256; }
            bf16_t* base = base0 + boff;
#pragma unroll
            for (int ai = 0; ai < 2; ++ai)
#pragma unroll
                for (int m = 0; m < 4; ++m) {
                    bf16_t* rowp = base + (size_t)(row0 + ai * HALF + m * 16) * ldc + colt + wc * 32 + 4 * fq;
#pragma unroll
                    for (int bj = 0; bj < 2; ++bj)
#pragma unroll
                        for (int n = 0; n < 2; ++n) {
                            f32x4 v = acc[ai][bj][m][n];
                            if (!isf) { v[0] = sigmoid_f(v[0]); v[1] = sigmoid_f(v[1]); v[2] = sigmoid_f(v[2]); v[3] = sigmoid_f(v[3]); }
                            u32x2 w; w.x = cvt_pk_bf16(v[0], v[1]); w.y = cvt_pk_bf16(v[2], v[3]);
                            if (isf) __hip_atomic_store((unsigned long long*)(rowp + bj * HALF + n * 16), ((unsigned long long)w.y << 32) | w.x, __ATOMIC_RELAXED, __HIP_MEMORY_SCOPE_AGENT);
                            else *(u32x2*)(rowp + bj * HALF + n * 16) = w;
                        }
                }
            if (isf) {
                asm volatile("s_waitcnt vmcnt(0)" ::: "memory");
                if (fr == 0 && fq == 0) __hip_atomic_fetch_add(fcnt, 1u, __ATOMIC_RELAXED, __HIP_MEMORY_SCOPE_AGENT);
            }
        }
    }
};

struct EpiMerge {
    static constexpr bool PERM = true, AFTER_DRAIN = false; static constexpr int MID_T = 8;
    const bf16_t *GA, *GF; bf16_t* O;
    __device__ __forceinline__ void mid(f32x4 (&acc)[2][2][4][2], const Unit& u, int wr, int wc, int fr, int fq) const {
        const unsigned loff = (unsigned)(wr * 64 + fr) * 1024u + wc * 32 + 8 * fq;
        const size_t uoff = (size_t)(__builtin_amdgcn_readfirstlane(u.pm) * BM) * 1024 + __builtin_amdgcn_readfirstlane(u.pn) * BM;
#pragma unroll
        for (int ai = 0; ai < 2; ++ai)
#pragma unroll
            for (int m = 0; m < 4; ++m) { const bf16_t* pa = GA + uoff + (size_t)(ai * HALF + m * 16) * 1024; const bf16_t* pf = GF + uoff + (size_t)(ai * HALF + m * 16) * 1024;
#pragma unroll
                for (int bj = 0; bj < 2; ++bj) {
                    const u32x4 a = __builtin_nontemporal_load((const u32x4*)(pa + bj * HALF + loff)), f = *(const u32x4*)(pf + bj * HALF + loff);
                    f32x4 r0, r1;
                    r0[0] = bf_lo(a.x) * __builtin_amdgcn_rcpf(bf_lo(f.x)); r0[1] = bf_hi(a.x) * __builtin_amdgcn_rcpf(bf_hi(f.x));
                    r0[2] = bf_lo(a.y) * __builtin_amdgcn_rcpf(bf_lo(f.y)); r0[3] = bf_hi(a.y) * __builtin_amdgcn_rcpf(bf_hi(f.y));
                    r1[0] = bf_lo(a.z) * __builtin_amdgcn_rcpf(bf_lo(f.z)); r1[1] = bf_hi(a.z) * __builtin_amdgcn_rcpf(bf_hi(f.z));
                    r1[2] = bf_lo(a.w) * __builtin_amdgcn_rcpf(bf_lo(f.w)); r1[3] = bf_hi(a.w) * __builtin_amdgcn_rcpf(bf_hi(f.w));
                    acc[ai][bj][m][0] = acc[ai][bj][m][0] * r0; acc[ai][bj][m][1] = acc[ai][bj][m][1] * r1;
                }
                asm volatile("" : "+v"(acc[ai][0][m][0]), "+v"(acc[ai][0][m][1]), "+v"(acc[ai][1][m][0]), "+v"(acc[ai][1][m][1]));
                asm volatile("" ::: "memory"); }
    }
    __device__ __forceinline__ void operator()(const f32x4 (&acc)[2][2][4][2], const Unit& u, int wr, int wc, int fr, int fq) const {
        const unsigned loff = (unsigned)(wr * 64 + fr) * 1024u + wc * 32 + 8 * fq;
        const size_t uoff = (size_t)(__builtin_amdgcn_readfirstlane(u.pm) * BM) * 1024 + __builtin_amdgcn_readfirstlane(u.pn) * BM;
#pragma unroll
        for (int ai = 0; ai < 2; ++ai)
#pragma unroll
            for (int m = 0; m < 4; ++m) { const bf16_t* pf = GF + uoff + (size_t)(ai * HALF + m * 16) * 1024; bf16_t* po = O + uoff + (size_t)(ai * HALF + m * 16) * 1024;
#pragma unroll
                for (int bj = 0; bj < 2; ++bj) {
                    const u32x4 f = *(const u32x4*)(pf + bj * HALF + loff);
                    const f32x4 v0 = acc[ai][bj][m][0], v1 = acc[ai][bj][m][1];
                    u32x4 w;
                    w.x = cvt_pk_bf16(v0[0] * bf_lo(f.x), v0[1] * bf_hi(f.x)); w.y = cvt_pk_bf16(v0[2] * bf_lo(f.y), v0[3] * bf_hi(f.y));
                    w.z = cvt_pk_bf16(v1[0] * bf_lo(f.z), v1[1] * bf_hi(f.z)); w.w = cvt_pk_bf16(v1[2] * bf_lo(f.w), v1[3] * bf_hi(f.w));
                    *(u32x4*)(po + bj * HALF + loff) = w;
                }
                asm volatile("" ::: "memory"); }
    }
};


__device__ __forceinline__ float dpp_ror1(float x) { return __int_as_float(__builtin_amdgcn_mov_dpp(__float_as_int(x), 0x121, 0xf, 0xf, true)); }
__device__ __forceinline__ float dpp_rol1(float x) { return __int_as_float(__builtin_amdgcn_mov_dpp(__float_as_int(x), 0x12f, 0xf, 0xf, true)); }
struct EpiUp {
    static constexpr bool PERM = true, AFTER_DRAIN = false; static constexpr int MID_T = 0;
    const float* cw; const float* cb; bf16_t* O;
    __device__ __forceinline__ void operator()(const f32x4 (&acc)[2][2][4][2], const Unit& u, int wr, int wc, int fr, int fq) const {
        const int pm = __builtin_amdgcn_readfirstlane(u.pm), pn = __builtin_amdgcn_readfirstlane(u.pn);
        const int ch0 = pn * 128 + wc * 32 + 8 * fq;
        float w0[8], w1[8], w2[8], bb[8];
#pragma unroll
        for (int h = 0; h < 2; ++h) {
            const f32x4 a = *(const f32x4*)(cw + ch0 + 4 * h), b = *(const f32x4*)(cw + 2816 + ch0 + 4 * h), c = *(const f32x4*)(cw + 2 * 2816 + ch0 + 4 * h), d = *(const f32x4*)(cb + ch0 + 4 * h);
#pragma unroll
            for (int j = 0; j < 4; ++j) { w0[4 * h + j] = a[j]; w1[4 * h + j] = b[j]; w2[4 * h + j] = c[j]; bb[4 * h + j] = d[j]; }
        }
#pragma unroll
        for (int ai = 0; ai < 2; ++ai) {
            const int tok0 = 248 * pm + 62 * (2 * ai + wr) - 1 + fr;
            float av[4][8];
#pragma unroll
            for (int n = 0; n < 2; ++n)
#pragma unroll
                for (int j = 0; j < 4; ++j) {
                    float uu[4], rr[4], ll[4];
#pragma unroll
                    for (int m = 0; m < 4; ++m) { uu[m] = acc[ai][0][m][n][j]; rr[m] = dpp_ror1(uu[m]); ll[m] = dpp_rol1(uu[m]); }
#pragma unroll
                    for (int m = 0; m < 4; ++m) {
                        float pv = (fr == 0) ? (m > 0 ? rr[m > 0 ? m - 1 : 0] : 0.f) : rr[m];
                        float nx = (fr == 15) ? (m < 3 ? ll[m < 3 ? m + 1 : 3] : 0.f) : ll[m];
                        const int sb = (tok0 + 16 * m) & 8191;
                        if (sb == 0) pv = 0.f;
                        if (sb == 8191) nx = 0.f;
                        const float cv = pv * w0[4 * n + j] + uu[m] * w1[4 * n + j] + nx * w2[4 * n + j] + bb[4 * n + j];
                        av[m][4 * n + j] = cv * __builtin_amdgcn_rcpf(1.0f + __expf(-cv)) * acc[ai][1][m][n][j];
                    }
                }
#pragma unroll
            for (int m = 0; m < 4; ++m) {
                const int i = 16 * m + fr, tok = tok0 + 16 * m;
                if (i >= 1 && i <= 62 && tok < 16384) {
                    u32x4 w; w.x = cvt_pk_bf16(av[m][0], av[m][1]); w.y = cvt_pk_bf16(av[m][2], av[m][3]); w.z = cvt_pk_bf16(av[m][4], av[m][5]); w.w = cvt_pk_bf16(av[m][6], av[m][7]);
                    *(u32x4*)(O + (size_t)tok * 2816 + ch0) = w;
                }
            }
        }
    }
};

struct OrderIn {
    StaticOrder so; int G, c;
    __device__ void init(int G_, int c_) { so.init(16384, 3328, G_, c_); G = G_; c = c_; }
    __device__ bool next(int i, Unit& u) const {
        const long L = (long)i * G + c;
        if (L < so.nwg) return so.next(i, u);
        if (L < so.nwg + 2) { u.pm = 64 + (int)(L - so.nwg); u.pn = 2; return true; }
        return false;
    }
    __device__ __forceinline__ void a_ready(const Unit&) const {}
    __device__ __forceinline__ void done(const Unit&) const {}
};
template <class Epi, class Sched, bool ALIGN_EPI = false, bool SP2 = false>
__device__ __forceinline__ void gemm_phase(PG8_LAS unsigned char* lds, const Gemm g, const Sched& S, const Epi& E) {
    int tid_ = threadIdx.x; asm volatile("" : "+v"(tid_));
    const int tid = tid_, wid = __builtin_amdgcn_readfirstlane(tid >> 6), lane = tid & 63, wr = wid >> 2, wc = wid & 3, fr = lane & 15, fq = lane >> 4;
    const int K = g.K, nt = K / BK;
    unsigned voffA[2], voffB[2];
#pragma unroll
    for (int i = 0; i < 2; ++i) { int R, C; stage_rc(tid * 16 + i * 8192, R, C); const int Rb = Epi::PERM ? ((R & ~31) + perm32(R & 31)) : R;
        voffA[i] = (unsigned)(((R & 63) + g.strip * (R >> 6)) * K + C) * 2u; voffB[i] = (unsigned)(Rb * K + C) * 2u; }
    const size_t kstep = (size_t)(BK * 2);
    const size_t hstep = (size_t)HALF * K * 2;
    const size_t tstep = 2 * hstep;
    const size_t hstepA = (size_t)(2 * g.strip) * K * 2, tstepA = 2 * hstepA;
    const long abias = (g.strip == 64) ? 0 : -(long)K * 2;
    const unsigned ldsw = (unsigned)wid * 1024u;
    const int aoff = lds_byte(wr * 64 + fr, fq * 8), boff = lds_byte(wc * 32 + fr, fq * 8);
#define PG8_SA(b, h) (((b) * 2 + (h)) * HTB)
#define PG8_SB(b, h) ((4 + (b) * 2 + (h)) * HTB)
#define PG8_STAGE(bufoff, gbase, voff) do { _Pragma("unroll") for (int _i = 0; _i < 2; ++_i) \
        __builtin_amdgcn_global_load_lds((const unsigned*)((const char*)(gbase) + (voff)[_i]), (PG8_LAS unsigned*)(lds + (bufoff) + ldsw + _i * 8192), 16, 0, 0); } while (0)
#define PG8_LDA(dst, b, h) do { _Pragma("unroll") for (int m = 0; m < 4; ++m) _Pragma("unroll") for (int k = 0; k < 2; ++k) dst[m][k] = *(const PG8_LAS bf16x8*)(lds + PG8_SA(b, h) + aoff + m * 2048 + k * 1024); } while (0)
#define PG8_LDB(dst, b, h) do { _Pragma("unroll") for (int n = 0; n < 2; ++n) _Pragma("unroll") for (int k = 0; k < 2; ++k) dst[n][k] = *(const PG8_LAS bf16x8*)(lds + PG8_SB(b, h) + boff + n * 2048 + k * 1024); } while (0)
#define PG8_MMA(ai, bj, At, Bt) do { __builtin_amdgcn_s_setprio(1); _Pragma("unroll") for (int m = 0; m < 4; ++m) _Pragma("unroll") for (int n = 0; n < 2; ++n) _Pragma("unroll") for (int k = 0; k < 2; ++k) \
        acc[ai][bj][m][n] = __builtin_amdgcn_mfma_f32_16x16x32_bf16(Bt[n][k], At[m][k], acc[ai][bj][m][n], 0, 0, 0); __builtin_amdgcn_s_setprio(0); } while (0)
#define PG8_WAIT_V(n) asm volatile("s_waitcnt vmcnt(" #n ")" ::: "memory")
#define PG8_WAIT_L(n) asm volatile("s_waitcnt lgkmcnt(" #n ")" ::: "memory")
#define PG8_BAR __builtin_amdgcn_s_barrier()
#define PG8_SCHED __builtin_amdgcn_sched_barrier(0)
    Unit cur, nxt; int ui = 0;
    if (!S.next(0, cur)) return;
    f32x4 acc[2][2][4][2];
#pragma unroll
    for (int a = 0; a < 2; ++a)
#pragma unroll
        for (int b = 0; b < 2; ++b)
#pragma unroll
            for (int m = 0; m < 4; ++m)
#pragma unroll
                for (int n = 0; n < 2; ++n) acc[a][b][m][n] = (f32x4){0.f, 0.f, 0.f, 0.f};
    bf16x8 At[4][2], B0[2][2], B1[2][2];
    const char* cA = (const char*)g.A + (size_t)cur.pm * tstepA + abias; const char* cB = (const char*)g.Bt + (size_t)cur.pn * tstep;
    S.a_ready(cur);
    if constexpr (SP2) {
        PG8_STAGE(PG8_SB(0, 0), cB, voffB); PG8_STAGE(PG8_SB(0, 1), cB + hstep, voffB); PG8_STAGE(PG8_SA(0, 0), cA, voffA); PG8_STAGE(PG8_SA(0, 1), cA + hstepA, voffA);
        if (wr == 1) PG8_BAR;
        PG8_WAIT_V(2); PG8_BAR;
        PG8_STAGE(PG8_SB(1, 0), cB + kstep, voffB); PG8_STAGE(PG8_SA(1, 0), cA + kstep, voffA); PG8_STAGE(PG8_SB(1, 1), cB + hstep + kstep, voffB);
        PG8_WAIT_V(6); PG8_BAR;
    } else {
        PG8_STAGE(PG8_SB(0, 0), cB, voffB); PG8_STAGE(PG8_SA(0, 0), cA, voffA); PG8_STAGE(PG8_SB(0, 1), cB + hstep, voffB); PG8_STAGE(PG8_SA(0, 1), cA + hstepA, voffA);
        if (wr == 1) PG8_BAR;
        PG8_WAIT_V(4); PG8_BAR;
        PG8_STAGE(PG8_SB(1, 0), cB + kstep, voffB); PG8_STAGE(PG8_SA(1, 0), cA + kstep, voffA); PG8_STAGE(PG8_SB(1, 1), cB + hstep + kstep, voffB);
        PG8_WAIT_V(6); PG8_BAR;
    }
    for (;;) {
        const bool has_next = S.next(ui + 1, nxt);
        const char* nA = has_next ? (const char*)g.A + (size_t)nxt.pm * tstepA + abias : cA; const char* nB = has_next ? (const char*)g.Bt + (size_t)nxt.pn * tstep : cB;
        for (int t = 0; t < nt; t += 2) {
            if constexpr (Epi::MID_T > 0) { if (t == Epi::MID_T) E.mid(acc, cur, wr, wc, fr, fq); }
            const bool last = (t == nt - 2);
            const char* a1 = cA + (size_t)(t + 1) * kstep;
            const char* a2 = last ? nA : cA + (size_t)(t + 2) * kstep; const char* b2 = last ? nB : cB + (size_t)(t + 2) * kstep;
            const char* a3 = a2 + kstep; const char* b3 = b2 + kstep;
            if (last && has_next) S.a_ready(nxt);
            if constexpr (SP2) {
            PG8_LDB(B0, 0, 0); PG8_LDB(B1, 0, 1); PG8_SCHED; PG8_LDA(At, 0, 0); PG8_STAGE(PG8_SA(1, 1), a1 + hstepA, voffA);
            PG8_WAIT_V(8); PG8_WAIT_L(0); PG8_BAR; PG8_MMA(0, 0, At, B0); PG8_MMA(0, 1, At, B1); PG8_BAR; PG8_SCHED;
            PG8_LDA(At, 0, 1); PG8_STAGE(PG8_SB(0, 0), b2, voffB); PG8_STAGE(PG8_SB(0, 1), b2 + hstep, voffB); PG8_STAGE(PG8_SA(0, 0), a2, voffA);
            PG8_WAIT_V(8); PG8_WAIT_L(0); PG8_BAR; PG8_MMA(1, 0, At, B0); PG8_MMA(1, 1, At, B1); PG8_BAR; PG8_SCHED;
            PG8_LDB(B0, 1, 0); PG8_LDB(B1, 1, 1); PG8_SCHED; PG8_LDA(At, 1, 0); PG8_STAGE(PG8_SA(0, 1), a2 + hstepA, voffA);
            PG8_WAIT_V(8); PG8_WAIT_L(0); PG8_BAR; PG8_MMA(0, 0, At, B0); PG8_MMA(0, 1, At, B1); PG8_BAR; PG8_SCHED;
            PG8_LDA(At, 1, 1); PG8_STAGE(PG8_SB(1, 0), b3, voffB); PG8_STAGE(PG8_SB(1, 1), b3 + hstep, voffB); PG8_STAGE(PG8_SA(1, 0), a3, voffA);
            PG8_WAIT_V(8); PG8_WAIT_L(0); PG8_BAR; PG8_MMA(1, 0, At, B0); PG8_MMA(1, 1, At, B1); PG8_BAR; PG8_SCHED;
            } else {
            PG8_LDB(B0, 0, 0); PG8_SCHED; PG8_LDA(At, 0, 0); PG8_STAGE(PG8_SA(1, 1), a1 + hstepA, voffA);
            PG8_WAIT_L(8); PG8_BAR; PG8_WAIT_L(0); PG8_MMA(0, 0, At, B0); PG8_BAR; PG8_SCHED;
            PG8_LDB(B1, 0, 1); PG8_STAGE(PG8_SB(0, 0), b2, voffB);
            PG8_BAR; PG8_WAIT_L(0); PG8_MMA(0, 1, At, B1); PG8_BAR;
            PG8_LDA(At, 0, 1); PG8_STAGE(PG8_SA(0, 0), a2, voffA);
            PG8_BAR; PG8_WAIT_L(0); PG8_MMA(1, 0, At, B0); PG8_BAR; PG8_SCHED;
            PG8_STAGE(PG8_SB(0, 1), b2 + hstep, voffB);
            PG8_WAIT_V(6); PG8_BAR; PG8_MMA(1, 1, At, B1); PG8_BAR;
            PG8_LDB(B0, 1, 0); PG8_SCHED; PG8_LDA(At, 1, 0); PG8_STAGE(PG8_SA(0, 1), a2 + hstepA, voffA);
            PG8_WAIT_L(8); PG8_BAR; PG8_WAIT_L(0); PG8_MMA(0, 0, At, B0); PG8_BAR; PG8_SCHED;
            PG8_LDB(B1, 1, 1); PG8_STAGE(PG8_SB(1, 0), b3, voffB);
            PG8_BAR; PG8_WAIT_L(0); PG8_MMA(0, 1, At, B1); PG8_BAR;
            PG8_LDA(At, 1, 1); PG8_STAGE(PG8_SA(1, 0), a3, voffA);
            PG8_BAR; PG8_WAIT_L(0); PG8_MMA(1, 0, At, B0); PG8_BAR; PG8_SCHED;
            PG8_STAGE(PG8_SB(1, 1), b3 + hstep, voffB);
            PG8_WAIT_V(6); PG8_BAR; PG8_MMA(1, 1, At, B1); PG8_BAR;
            }
        }
        if constexpr (ALIGN_EPI) { if (wr == 0) PG8_BAR; }
        if constexpr (!Epi::AFTER_DRAIN) { E(acc, cur, wr, wc, fr, fq); S.done(cur); }
        if (!has_next) break;
#pragma unroll
        for (int a = 0; a < 2; ++a)
#pragma unroll
            for (int b = 0; b < 2; ++b)
#pragma unroll
                for (int m = 0; m < 4; ++m)
#pragma unroll
                    for (int n = 0; n < 2; ++n) acc[a][b][m][n] = (f32x4){0.f, 0.f, 0.f, 0.f};
        cur = nxt; cA = nA; cB = nB; ++ui;
        if constexpr (ALIGN_EPI) { if (wr == 1) PG8_BAR; }
    }
    PG8_WAIT_V(0);
    if constexpr (!ALIGN_EPI) { if (wr == 0) PG8_BAR; }
    PG8_BAR;
    if constexpr (Epi::AFTER_DRAIN) { E.fused(acc, cur, wr, wc, fr, fq, lds, wid, lane); S.done(cur); }
#undef PG8_SA
#undef PG8_SB
#undef PG8_STAGE
#undef PG8_LDA
#undef PG8_LDB
#undef PG8_MMA
#undef PG8_WAIT_V
#undef PG8_WAIT_L
#undef PG8_BAR
#undef PG8_SCHED
}
}
#include <cmath>
#define GAS __attribute__((address_space(1)))
#define LAS __attribute__((address_space(3)))
typedef unsigned short bf16;
typedef unsigned v4u __attribute__((ext_vector_type(4)));
typedef float f32x4 __attribute__((ext_vector_type(4)));
typedef short bf16x8 __attribute__((ext_vector_type(8)));
typedef GAS unsigned gu32;
typedef GAS unsigned long long gu64;
#define RLX_AGENT __ATOMIC_RELAXED, __HIP_MEMORY_SCOPE_AGENT
#define LDS_WAIT() asm volatile("s_waitcnt lgkmcnt(0)" ::: "memory")
#define VM_WAIT() asm volatile("s_waitcnt vmcnt(0)" ::: "memory")
__device__ __forceinline__ unsigned long long rt() { return __builtin_amdgcn_s_memrealtime(); }
__device__ __forceinline__ unsigned f2bf(float f) { unsigned u = __builtin_bit_cast(unsigned, f); return (u + 0x7fffu + ((u >> 16) & 1u)) >> 16; }
__device__ __forceinline__ unsigned pk2(float lo, float hi) { return f2bf(lo) | (f2bf(hi) << 16); }

#define XB_TMO      128
#define XB_XCNT(j)  (256  + 64 * (j))
#define XB_XSUB(j)  (1280 + 64 * (j))
#define XB_XGEN(j)  (2304 + 64 * (j))
#define XB_TOP      3328
#define XB_TOPGEN   3392
#define XCD_BAR_WORDS 3456
#define XB_SPIN_CAP (1u << 18)

__device__ __forceinline__ unsigned xb_ld(unsigned* p)              { return __hip_atomic_load(p, __ATOMIC_RELAXED, __HIP_MEMORY_SCOPE_AGENT); }
__device__ __forceinline__ unsigned xb_add(unsigned* p, unsigned v) { return __hip_atomic_fetch_add(p, v, __ATOMIC_RELAXED, __HIP_MEMORY_SCOPE_AGENT); }
__device__ __forceinline__ unsigned xb_xcc_id() { return (unsigned)__builtin_amdgcn_s_getreg((3 << 11) | 20) & 0xFu; }
#define XB_SPIN(cond, bar) do { unsigned _sp = 0; while (cond) { __builtin_amdgcn_s_sleep(1); \
    if ((++_sp & 255u) == 0u) { if (xb_ld(&(bar)[XB_TMO])) break; if (_sp > XB_SPIN_CAP) { atomicAdd(&(bar)[XB_TMO], 1u); break; } } } } while (0)

struct XcdBarrier {
    unsigned* bar; unsigned x;
    volatile LAS unsigned* st;
};

__device__ __forceinline__ XcdBarrier xcd_barrier_post(unsigned* bar, volatile LAS unsigned* st) {
    XcdBarrier b; b.bar = bar; b.x = xb_xcc_id(); b.st = st;
    if (threadIdx.x == 0) (void)xb_add(&bar[XB_XCNT(b.x)], 1u);
    return b;
}
__device__ __forceinline__ void xcd_barrier_complete(unsigned* bar, unsigned x, unsigned& nloc, unsigned& nx) {
    const unsigned G = gridDim.x * gridDim.y * gridDim.z;
    unsigned sum, cnt, mine, sp = 0u;
    for (;;) {
        sum = 0u; cnt = 0u; mine = 0u;
#pragma unroll
        for (unsigned j = 0; j < 16; ++j) { const unsigned c = xb_ld(&bar[XB_XCNT(j)]); sum += c; cnt += (c > 0u) ? 1u : 0u; mine = (j == x) ? c : mine; }
        if (sum == G) break;
        __builtin_amdgcn_s_sleep(1);
        if ((++sp & 255u) == 0u) { if (xb_ld(&bar[XB_TMO])) break; if (sp > XB_SPIN_CAP) { atomicAdd(&bar[XB_TMO], 1u); break; } }
    }
    nloc = mine > 0u ? mine : 1u; nx = cnt > 0u ? cnt : 1u;
}

__device__ __forceinline__ void xcd_barrier(const XcdBarrier& b) {
    asm volatile("s_waitcnt vmcnt(0)" ::: "memory");
    __syncthreads();
    if (threadIdx.x == 0) {
        unsigned* bar = b.bar;
        __builtin_amdgcn_s_waitcnt(0);
        unsigned nloc = b.st[0], nx = b.st[1];
        if (nloc == 0u) { xcd_barrier_complete(bar, b.x, nloc, nx); b.st[0] = nloc; b.st[1] = nx; }
        const unsigned old = xb_add(&bar[XB_XSUB(b.x)], 1u);
        const unsigned gen = old / nloc;
        if (old + 1u == (gen + 1u) * nloc) {
            __builtin_amdgcn_fence(__ATOMIC_RELEASE, "agent");
            asm volatile("s_waitcnt vmcnt(0)" ::: "memory");
            const unsigned og = xb_add(&bar[XB_TOP], 1u);
            const unsigned tg = og / nx;
            if (og + 1u == (tg + 1u) * nx) xb_add(&bar[XB_TOPGEN], 1u);
            else XB_SPIN(xb_ld(&bar[XB_TOPGEN]) == tg, bar);
            __builtin_amdgcn_fence(__ATOMIC_ACQUIRE, "agent");
            xb_add(&bar[XB_XGEN(b.x)], 1u);
            asm volatile("s_waitcnt vmcnt(0)" ::: "memory");
        } else {
            XB_SPIN(xb_ld(&bar[XB_XGEN(b.x)]) == gen, bar);
            __builtin_amdgcn_fence(__ATOMIC_ACQUIRE, "agent");
            asm volatile("s_waitcnt vmcnt(0)" ::: "memory");
        }
    }
    __syncthreads();
}
__device__ __forceinline__ float sumsq4(pg8::f32x4 v) { return (v[0] * v[0] + v[1] * v[1]) + (v[2] * v[2] + v[3] * v[3]); }
__device__ __forceinline__ void row_sumsq_publish(const pg8::f32x4 (&acc)[2][2][4][2], float* rs, int row0, int fq) {
#pragma unroll
    for (int ai = 0; ai < 2; ++ai)
#pragma unroll
        for (int m = 0; m < 4; ++m) {
            float s = (sumsq4(acc[ai][0][m][0]) + sumsq4(acc[ai][0][m][1])) + (sumsq4(acc[ai][1][m][0]) + sumsq4(acc[ai][1][m][1]));
            s += __shfl_xor(s, 16); s += __shfl_xor(s, 32);
            if (fq == 0) unsafeAtomicAdd(rs + row0 + ai * 128 + m * 16, s);
        }
}
__device__ __forceinline__ void panel_barrier(unsigned* cnt, unsigned target) {
    asm volatile("s_waitcnt vmcnt(0)" ::: "memory");
    __syncthreads();
    if (threadIdx.x == 0) {
        __hip_atomic_fetch_add(cnt, 1u, __ATOMIC_RELAXED, __HIP_MEMORY_SCOPE_AGENT);
        unsigned spins = 0;
        while (__hip_atomic_load(cnt, __ATOMIC_RELAXED, __HIP_MEMORY_SCOPE_AGENT) < target) { __builtin_amdgcn_s_sleep(1); if (++spins > (1u << 22)) break; }
    }
    __syncthreads();
}
struct EpiOutNorm {
    static constexpr bool PERM = true, AFTER_DRAIN = true; static constexpr int MID_T = 0;
    const float* x; pg8::bf16_t* X1; pg8::bf16_t* H; const float* mod; const float* g_post1; const float* g_pre2; float* rs1; float* rs2; unsigned* pcnt;
    __device__ __forceinline__ void fused(pg8::f32x4 (&acc)[2][2][4][2], const pg8::Unit& u, int wr, int wc, int fr, int fq, PG8_LAS unsigned char*, int, int) const {
        using pg8::f32x4;
        const int pm = __builtin_amdgcn_readfirstlane(u.pm), pn = __builtin_amdgcn_readfirstlane(u.pn);
        const int row0 = pm * 256 + wr * 64 + fr, col0 = pn * 256 + wc * 32 + 8 * fq;
        const float* mb = mod + (pm >> 5) * 6144;
        row_sumsq_publish(acc, rs1, row0, fq);
        panel_barrier(pcnt + pm, 4u);
        {
            f32x4 gg[2][2];
#pragma unroll
            for (int bj = 0; bj < 2; ++bj)
#pragma unroll
                for (int n = 0; n < 2; ++n) gg[bj][n] = *(const f32x4*)(g_post1 + col0 + bj * 128 + 4 * n) * *(const f32x4*)(mb + 2048 + col0 + bj * 128 + 4 * n);
#pragma unroll
            for (int ai = 0; ai < 2; ++ai)
#pragma unroll
                for (int m = 0; m < 4; ++m) {
                    const int row = row0 + ai * 128 + m * 16;
                    const float rstd = rsqrtf(__hip_atomic_load(rs1 + row, __ATOMIC_RELAXED, __HIP_MEMORY_SCOPE_AGENT) * (1.f / 1024.f) + 1e-6f);
                    const size_t off = (size_t)row * 1024 + col0;
                    float s2 = 0.f;
#pragma unroll
                    for (int bj = 0; bj < 2; ++bj) {
#pragma unroll
                        for (int n = 0; n < 2; ++n) {
                            const f32x4 xv = __builtin_nontemporal_load((const f32x4*)(x + off + bj * 128 + 4 * n));
                            const f32x4 x1 = xv + gg[bj][n] * (acc[ai][bj][m][n] * rstd);
                            acc[ai][bj][m][n] = x1;
                            s2 += sumsq4(x1);
                        }
                        const f32x4 a0 = acc[ai][bj][m][0], a1 = acc[ai][bj][m][1];
                        pg8::u32x4 w; w.x = pg8::cvt_pk_bf16(a0[0], a0[1]); w.y = pg8::cvt_pk_bf16(a0[2], a0[3]); w.z = pg8::cvt_pk_bf16(a1[0], a1[1]); w.w = pg8::cvt_pk_bf16(a1[2], a1[3]);
                        *(pg8::u32x4*)(X1 + off + bj * 128) = w;
                    }
                    s2 += __shfl_xor(s2, 16); s2 += __shfl_xor(s2, 32);
                    if (fq == 0) unsafeAtomicAdd(rs2 + row, s2);
                    asm volatile("" : "+v"(acc[ai][0][m][0]), "+v"(acc[ai][0][m][1]), "+v"(acc[ai][1][m][0]), "+v"(acc[ai][1][m][1]));
                    if (m & 1) asm volatile("" ::: "memory");
                }
        }
        panel_barrier(pcnt + 64 + pm, 4u);
        {
            f32x4 gp[2][2], sh[2][2];
#pragma unroll
            for (int bj = 0; bj < 2; ++bj)
#pragma unroll
                for (int n = 0; n < 2; ++n) { gp[bj][n] = *(const f32x4*)(g_pre2 + col0 + bj * 128 + 4 * n) * (*(const f32x4*)(mb + 4096 + col0 + bj * 128 + 4 * n) + 1.0f); sh[bj][n] = *(const f32x4*)(mb + 3072 + col0 + bj * 128 + 4 * n); }
#pragma unroll
            for (int ai = 0; ai < 2; ++ai)
#pragma unroll
                for (int m = 0; m < 4; ++m) {
                    const int row = row0 + ai * 128 + m * 16;
                    const float rstd = rsqrtf(__hip_atomic_load(rs2 + row, __ATOMIC_RELAXED, __HIP_MEMORY_SCOPE_AGENT) * (1.f / 1024.f) + 1e-6f);
#pragma unroll
                    for (int bj = 0; bj < 2; ++bj) {
                        const f32x4 h0 = (acc[ai][bj][m][0] * rstd) * gp[bj][0] + sh[bj][0], h1 = (acc[ai][bj][m][1] * rstd) * gp[bj][1] + sh[bj][1];
                        pg8::u32x4 w; w.x = pg8::cvt_pk_bf16(h0[0], h0[1]); w.y = pg8::cvt_pk_bf16(h0[2], h0[3]); w.z = pg8::cvt_pk_bf16(h1[0], h1[1]); w.w = pg8::cvt_pk_bf16(h1[2], h1[3]);
                        *(pg8::u32x4*)(H + (size_t)row * 1024 + col0 + bj * 128) = w;
                    }
                }
        }
    }
};
struct EpiDownNorm {
    static constexpr bool PERM = true, AFTER_DRAIN = true; static constexpr int MID_T = 0;
    const pg8::bf16_t* X1; float* out; const float* mod; const float* g_post2; float* rs3; unsigned* pcnt;
    __device__ __forceinline__ void fused(pg8::f32x4 (&acc)[2][2][4][2], const pg8::Unit& u, int wr, int wc, int fr, int fq, PG8_LAS unsigned char*, int, int) const {
        using pg8::f32x4;
        const int pm = __builtin_amdgcn_readfirstlane(u.pm), pn = __builtin_amdgcn_readfirstlane(u.pn);
        const int row0 = pm * 256 + wr * 64 + fr, col0 = pn * 256 + wc * 32 + 8 * fq;
        const float* mb = mod + (pm >> 5) * 6144;
        row_sumsq_publish(acc, rs3, row0, fq);
        panel_barrier(pcnt + pm, 4u);
        f32x4 gg[2][2];
#pragma unroll
        for (int bj = 0; bj < 2; ++bj)
#pragma unroll
            for (int n = 0; n < 2; ++n) gg[bj][n] = *(const f32x4*)(g_post2 + col0 + bj * 128 + 4 * n) * *(const f32x4*)(mb + 5120 + col0 + bj * 128 + 4 * n);
#pragma unroll
        for (int ai = 0; ai < 2; ++ai)
#pragma unroll
            for (int m = 0; m < 4; ++m) {
                const int row = row0 + ai * 128 + m * 16;
                const float rstd = rsqrtf(__hip_atomic_load(rs3 + row, __ATOMIC_RELAXED, __HIP_MEMORY_SCOPE_AGENT) * (1.f / 1024.f) + 1e-6f);
                const size_t off = (size_t)row * 1024 + col0;
#pragma unroll
                for (int bj = 0; bj < 2; ++bj) {
                    const pg8::u32x4 xw = *(const pg8::u32x4*)(X1 + off + bj * 128);
                    const f32x4 x0 = (f32x4){pg8::bf_lo(xw.x), pg8::bf_hi(xw.x), pg8::bf_lo(xw.y), pg8::bf_hi(xw.y)}, x1v = (f32x4){pg8::bf_lo(xw.z), pg8::bf_hi(xw.z), pg8::bf_lo(xw.w), pg8::bf_hi(xw.w)};
                    __builtin_nontemporal_store(x0 + gg[bj][0] * (acc[ai][bj][m][0] * rstd), (f32x4*)(out + off + bj * 128));
                    __builtin_nontemporal_store(x1v + gg[bj][1] * (acc[ai][bj][m][1] * rstd), (f32x4*)(out + off + bj * 128 + 4));
                }
                if (m & 1) asm volatile("" ::: "memory");
            }
    }
};

constexpr int NWAVES = 8;
constexpr int SEQ = 8192, DM = 1024, MTOK = 16384, MCTX = 512, MALL = MTOK + MCTX, INW = 3328, DFF = 2816;
constexpr float EPS = 1e-6f;
constexpr float QSCALE = 0.125f * 1.4426950408889634f;
constexpr int RING_BYTES = 131072, LDS_BYTES = 147456, LDSCTL_OFF = LDS_BYTES - 512, MISC_OFF = LDSCTL_OFF + 320;

__device__ __forceinline__ float wave_sum(float v) {
#pragma unroll
    for (int o = 1; o < 64; o <<= 1) v += __shfl_xor(v, o);
    return v;
}
__device__ __forceinline__ float silu_f(float x) { return x * __builtin_amdgcn_rcpf(1.0f + __expf(-x)); }

__device__ __forceinline__ void p0_transpose_item(const float* W, int K, int N, bf16* WT, int ldw, int up_perm, int koff, LAS float* scr, int item, int lane) {
    const int nblk = N / 32, kb = item / nblk, nb = item % nblk, k0 = 64 * kb, n0 = 32 * nb;
    int rbase = n0;
    if (up_perm) { const int half = n0 >= DFF ? 1 : 0, jj = n0 - half * DFF; rbase = (jj >> 7) * 256 + half * 128 + (jj & 127); }
#pragma unroll 8
    for (int i = 0; i < 32; ++i) { const int kk = 2 * i + (lane >> 5); scr[kk * 33 + (lane & 31)] = __builtin_nontemporal_load(&W[(size_t)(k0 + kk) * N + n0 + (lane & 31)]); }
    LDS_WAIT(); asm volatile("" ::: "memory");
    const int c = lane & 7;
#pragma unroll
    for (int j = 0; j < 4; ++j) { const int n = (lane >> 3) + 8 * j; const LAS float* s = scr + (8 * c) * 33 + n;
        v4u o; o.x = pk2(s[0 * 33], s[1 * 33]); o.y = pk2(s[2 * 33], s[3 * 33]); o.z = pk2(s[4 * 33], s[5 * 33]); o.w = pk2(s[6 * 33], s[7 * 33]);
        *(v4u*)(WT + (size_t)(rbase + n) * ldw + koff + k0 + 8 * c) = o; }
    LDS_WAIT(); asm volatile("" ::: "memory");
}

struct Args {
    const float *x, *c, *ctx, *c_ctx, *w_mod, *b_mod, *g_pre1, *g_post1, *g_pre2, *g_post2, *w_in, *sink, *w_pa, *w_pf, *w_out, *w_up, *conv_w, *conv_b, *w_down;
    float* out; unsigned char* ws;
};

__device__ __forceinline__ void p0a_adaln(const Args& A, int gw, int NGW, int lane) {
    float* mod = (float*)(A.ws + WS_CTL) + CW_MOD;
    for (int it = gw; it < 96 * 16; it += NGW) {
        const int cc = it % 96, kc = it / 96, col = cc * 64 + lane, k0 = kc * 64;
        const float s0 = silu_f(A.c[k0 + lane]), s1 = silu_f(A.c[1024 + k0 + lane]), s2 = silu_f(A.c_ctx[k0 + lane]);
        float a0 = 0.f, a1 = 0.f, a2 = 0.f;
        const float* wp = A.w_mod + (size_t)k0 * 6144 + col;
#pragma unroll 16
        for (int kk = 0; kk < 64; ++kk) {
            const float w = __builtin_nontemporal_load(wp + (size_t)kk * 6144);
            a0 += __shfl(s0, kk) * w; a1 += __shfl(s1, kk) * w; a2 += __shfl(s2, kk) * w;
        }
        if (kc == 0) { const float b = A.b_mod[col]; a0 += b; a1 += b; a2 += b; }
        unsafeAtomicAdd(mod + col, a0); unsafeAtomicAdd(mod + 6144 + col, a1); unsafeAtomicAdd(mod + 2 * 6144 + col, a2);
    }
}
__device__ __forceinline__ void p0b_win(const Args& A, LAS unsigned char* lds, int gw, int NGW, int wave, int lane) {
    bf16* WinT = (bf16*)(A.ws + WS_WIN);
    LAS float* scr = (LAS float*)(lds + wave * 16384);
    constexpr int I_IN = 16 * (INW / 32);
    for (int it = gw; it < I_IN; it += NGW) p0_transpose_item(A.w_in, 1024, INW, WinT, 1024, 0, 0, scr, it, lane);
}
__device__ __forceinline__ void p0_setup(const Args& A, LAS unsigned char* lds, int widx, int nw, int bidx, int nb, int wave, int lane, int tid) {
    unsigned char* ws = A.ws;
    bf16* WcatT = (bf16*)(ws + WS_WCAT);
    bf16* TA = (bf16*)(ws + WS_TAB); bf16* TB = TA + TA_ELEMS;
    LAS float* TT = (LAS float*)(lds + 8 * 16384 - 1024);
    if (tid < 128) { TT[tid] = cospif((float)tid * (1.0f / 64.0f)); TT[128 + tid] = sinpif((float)tid * (1.0f / 64.0f)); }
    __syncthreads();
    for (int e = widx * 64 + lane; e < TA_ELEMS + TB_ELEMS; e += nw * 64) {
        if (e < TA_ELEMS) {
            const int n = e >> 6, s1 = e & 63, T = n >> 4, c15 = n & 15, t = T >> 1, part = T & 1, k1 = 16 * t + c15, idx = (s1 * k1) & 63;
            const float a = (float)idx * (1.0f / 32.0f);
            TA[e] = (bf16)f2bf(part ? -sinpif(a) : cospif(a));
        } else {
            const int e2 = e - TA_ELEMS, n = e2 >> 8, K = e2 & 255, T = n >> 4, c15 = n & 15, t = T >> 1, pp = T & 1, k2 = 16 * t + c15, part = K >> 7, s2 = K & 127, idx = (s2 * k2) & 127;
            const float a = (float)idx * (1.0f / 64.0f); const float cv = cospif(a), sv = sinpif(a);
            TB[e2] = (bf16)f2bf(part == pp ? cv : (part == 1 ? sv : -sv));
        }
    }
    for (int it = bidx + nb * wave; it < 1024; it += nb * NWAVES) {
        const int g = it & 3, nch = (it >> 2) & 15, cch = it >> 6, n = nch * 64 + lane, c0 = cch * 8;
        float ar[8], ai[8];
#pragma unroll
        for (int cc = 0; cc < 8; ++cc) { ar[cc] = 0.f; ai[cc] = 0.f; }
        const float* wp = A.w_pf + (size_t)(g * 128) * 1024 + n;
#pragma unroll 4
        for (int cp = 0; cp < 128; ++cp) {
            const float w = __builtin_nontemporal_load(wp + (size_t)cp * 1024);
#pragma unroll
            for (int cc = 0; cc < 8; ++cc) { const int idx = ((c0 + cc) * cp) & 127; ar[cc] += TT[idx] * w; ai[cc] += TT[128 + idx] * w; }
        }
        bf16* dst = WcatT + (size_t)n * 1536 + 512 + g * 256 + c0;
        const float sc = 1.f / 1024.f;
        v4u o;
        o.x = pk2(ar[0] * sc, ar[1] * sc); o.y = pk2(ar[2] * sc, ar[3] * sc); o.z = pk2(ar[4] * sc, ar[5] * sc); o.w = pk2(ar[6] * sc, ar[7] * sc);
        *(v4u*)dst = o;
        o.x = pk2(ai[0] * sc, ai[1] * sc); o.y = pk2(ai[2] * sc, ai[3] * sc); o.z = pk2(ai[4] * sc, ai[5] * sc); o.w = pk2(ai[6] * sc, ai[7] * sc);
        *(v4u*)(dst + 128) = o;
    }
}
__device__ __forceinline__ void p0_deferred(const Args& A, LAS unsigned char* lds, int widx, int nw, int bidx, int nb, int wave, int lane, int tid) {
    unsigned char* ws = A.ws;
    bf16* WupT = (bf16*)(ws + WS_WUP); bf16* WdnT = (bf16*)(ws + WS_WDN); bf16* WoutT = (bf16*)(ws + WS_WOUT); bf16* WcatT = (bf16*)(ws + WS_WCAT);
    LAS float* scr = (LAS float*)(lds + wave * 16384);
    constexpr int I_PA = 8 * 32, I_OUT = 16 * 32, I_UP = 16 * (2 * DFF / 32), I_DN = (DFF / 64) * 32;
    for (int it = widx; it < I_PA + I_OUT + I_UP + I_DN; it += nw) {
        int r = it;
        if (r < I_PA) { p0_transpose_item(A.w_pa, 512, 1024, WcatT, 1536, 0, 0, scr, r, lane); continue; } r -= I_PA;
        if (r < I_OUT) { p0_transpose_item(A.w_out, 1024, 1024, WoutT, 1024, 0, 0, scr, r, lane); continue; } r -= I_OUT;
        if (r < I_UP) { p0_transpose_item(A.w_up, 1024, 2 * DFF, WupT, 1024, 1, 0, scr, r, lane); continue; } r -= I_UP;
        p0_transpose_item(A.w_down, DFF, 1024, WdnT, DFF, 0, 0, scr, r, lane);
    }
}
template <int R> __device__ __forceinline__ void p1_group(const float* src, bf16* dst, const f32x4 (&gs)[4], const f32x4 (&sh)[4], int lane) {
    f32x4 v[R][4]; float s[R];
#pragma unroll
    for (int r = 0; r < R; ++r) { const f32x4* xr = (const f32x4*)(src + (size_t)r * DM) + lane; s[r] = 0.f;
#pragma unroll
        for (int j = 0; j < 4; ++j) v[r][j] = __builtin_nontemporal_load(xr + 64 * j); }
#pragma unroll
    for (int r = 0; r < R; ++r)
#pragma unroll
        for (int j = 0; j < 4; ++j) s[r] += (v[r][j].x * v[r][j].x + v[r][j].y * v[r][j].y) + (v[r][j].z * v[r][j].z + v[r][j].w * v[r][j].w);
#pragma unroll
    for (int r = 0; r < R; ++r) {
        const float rs = rsqrtf(wave_sum(s[r]) * (1.f / DM) + EPS);
        unsigned long long* o8 = (unsigned long long*)(dst + (size_t)r * DM) + lane;
#pragma unroll
        for (int j = 0; j < 4; ++j) { const f32x4 h = (v[r][j] * rs) * gs[j] + sh[j]; o8[64 * j] = (unsigned long long)pk2(h.x, h.y) | ((unsigned long long)pk2(h.z, h.w) << 32); }
    }
}
__device__ __forceinline__ void p1_norm(const Args& A, int gw, int NGW, int lane) {
    const float* mod = (const float*)(A.ws + WS_CTL) + CW_MOD;
    bf16* H = (bf16*)(A.ws + WS_H);
    f32x4 g[4], gs[4], sh[4];
#pragma unroll
    for (int j = 0; j < 4; ++j) g[j] = ((const f32x4*)A.g_pre1)[lane + 64 * j];
    const int xg = gw >> 8, wl = gw & 255, mi = xg >> 2;
#pragma unroll
    for (int j = 0; j < 4; ++j) { gs[j] = g[j] * (((const f32x4*)(mod + mi * 6144 + 1024))[lane + 64 * j] + 1.0f); sh[j] = ((const f32x4*)(mod + mi * 6144))[lane + 64 * j]; }
    {
        const int wv = gw & 7, blk = gw >> 3;
        const int m0 = 2048 * xg + (blk & 31) * 64 + (wv < 4 ? wv * 6 : 24 + (wv - 4) * 10);
        p1_group<3>(A.x + (size_t)m0 * DM, H + (size_t)m0 * DM, gs, sh, lane);
        p1_group<3>(A.x + (size_t)(m0 + 3) * DM, H + (size_t)(m0 + 3) * DM, gs, sh, lane);
        if (wv >= 4) {
            p1_group<2>(A.x + (size_t)(m0 + 6) * DM, H + (size_t)(m0 + 6) * DM, gs, sh, lane);
            p1_group<2>(A.x + (size_t)(m0 + 8) * DM, H + (size_t)(m0 + 8) * DM, gs, sh, lane);
        }
    }
    if ((gw & 7) == 5 || (gw & 7) == 7) {
        const int ci = (gw >> 3) * 2 + (((gw & 7) == 7) ? 1 : 0);
#pragma unroll
        for (int j = 0; j < 4; ++j) { gs[j] = g[j] * (((const f32x4*)(mod + 2 * 6144 + 1024))[lane + 64 * j] + 1.0f); sh[j] = ((const f32x4*)(mod + 2 * 6144))[lane + 64 * j]; }
        p1_group<1>(A.ctx + (size_t)ci * DM, H + (size_t)(MTOK + ci) * DM, gs, sh, lane);
    }
}

__device__ __forceinline__ void attn_unit(const Args& A, LAS unsigned char* lds, int u, int wave, int lane, int tid) {
    const bf16* Q = (const bf16*)(A.ws + WS_Q); const bf16* Kb = (const bf16*)(A.ws + WS_K); const bf16* Vb = (const bf16*)(A.ws + WS_V);
    bf16* O = (bf16*)(A.ws + WS_ACAT);
    const int b = u >> 7, n = (u >> 1) & 63, h = u & 1;
    const int hq = h * 4 + (wave >> 1), qh = wave & 1;
    const int q0 = b * SEQ + n * 128 + qh * 64;
    const int fr = lane & 15, fq = lane >> 4;
    constexpr int KP = 72, VP = 136;
    LAS bf16* Ks = (LAS bf16*)lds; LAS bf16* Vt = (LAS bf16*)(lds + 128 * KP * 2);
    typedef float f32x16 __attribute__((ext_vector_type(16)));
    const int l31 = lane & 31, hh = lane >> 5, dperm = (l31 & ~12) | (((l31 >> 2) & 1) << 3) | (((l31 >> 3) & 1) << 2);
    (void)0;
    bf16x8 bq[2][4];
#pragma unroll
    for (int qt = 0; qt < 2; ++qt)
#pragma unroll
        for (int ks = 0; ks < 4; ++ks) bq[qt][ks] = *(const bf16x8*)(Q + (size_t)(q0 + qt * 32 + l31) * 512 + hq * 64 + ks * 16 + hh * 8);
    f32x16 oacc[2][2];
#pragma unroll
    for (int dt = 0; dt < 2; ++dt)
#pragma unroll
        for (int qt = 0; qt < 2; ++qt)
#pragma unroll
            for (int r = 0; r < 16; ++r) oacc[dt][qt][r] = 0.f;
    float mrun[2], lrun[2];
    const float sk = A.sink[hq] * 1.4426950408889634f;
#pragma unroll
    for (int qt = 0; qt < 2; ++qt) { mrun[qt] = sk; lrun[qt] = 0.f; }
    const int lrow = tid & 127, lseg = tid >> 7;
    v4u pk0, pk1, pv0, pv1;
    int c = (n == 0) ? 1 : 0;
    {
        const int krow0 = (c < 3) ? b * SEQ + (n - 1 + c) * 128 : MTOK + b * 256 + (c - 3) * 128;
        const bf16* kp = Kb + (size_t)(krow0 + lrow) * 128 + h * 64 + lseg * 16; const bf16* vp = Vb + (size_t)(krow0 + lrow) * 128 + h * 64 + lseg * 16;
        pk0 = *(const v4u*)kp; pk1 = *(const v4u*)(kp + 8); pv0 = *(const v4u*)vp; pv1 = *(const v4u*)(vp + 8);
    }
    while (c < 5) {
        __syncthreads();
        {
            *(LAS v4u*)(Ks + lrow * KP + lseg * 16) = pk0; *(LAS v4u*)(Ks + lrow * KP + lseg * 16 + 8) = pk1;
            LAS bf16* vd = Vt + (lseg * 16) * VP + lrow;
            vd[0 * VP] = (bf16)(pv0.x & 0xffff); vd[1 * VP] = (bf16)(pv0.x >> 16); vd[2 * VP] = (bf16)(pv0.y & 0xffff); vd[3 * VP] = (bf16)(pv0.y >> 16);
            vd[4 * VP] = (bf16)(pv0.z & 0xffff); vd[5 * VP] = (bf16)(pv0.z >> 16); vd[6 * VP] = (bf16)(pv0.w & 0xffff); vd[7 * VP] = (bf16)(pv0.w >> 16);
            vd[8 * VP] = (bf16)(pv1.x & 0xffff); vd[9 * VP] = (bf16)(pv1.x >> 16); vd[10 * VP] = (bf16)(pv1.y & 0xffff); vd[11 * VP] = (bf16)(pv1.y >> 16);
            vd[12 * VP] = (bf16)(pv1.z & 0xffff); vd[13 * VP] = (bf16)(pv1.z >> 16); vd[14 * VP] = (bf16)(pv1.w & 0xffff); vd[15 * VP] = (bf16)(pv1.w >> 16);
        }
        __syncthreads();
        int cn = c + 1; if (cn == 2 && n == 63) cn = 3;
        if (cn < 5) {
            const int krow0 = (cn < 3) ? b * SEQ + (n - 1 + cn) * 128 : MTOK + b * 256 + (cn - 3) * 128;
            const bf16* kp = Kb + (size_t)(krow0 + lrow) * 128 + h * 64 + lseg * 16; const bf16* vp = Vb + (size_t)(krow0 + lrow) * 128 + h * 64 + lseg * 16;
            pk0 = *(const v4u*)kp; pk1 = *(const v4u*)(kp + 8); pv0 = *(const v4u*)vp; pv1 = *(const v4u*)(vp + 8);
        }
        for (int sc = 0; sc < 4; ++sc) {
            if ((c == 0 && sc * 32 + 31 < qh * 64) || (c == 2 && sc * 32 > qh * 64 + 63)) continue;
            const bool mixed = (c == 0 && sc * 32 < qh * 64 + 63) || (c == 2 && sc * 32 + 31 > qh * 64);
            f32x16 s[2];
#pragma unroll
            for (int qt = 0; qt < 2; ++qt)
#pragma unroll
                for (int r = 0; r < 16; ++r) s[qt][r] = -mrun[qt];
#pragma unroll
            for (int ks = 0; ks < 4; ++ks) {
                const bf16x8 ka = *(const LAS bf16x8*)(Ks + (sc * 32 + l31) * KP + ks * 16 + hh * 8);
#pragma unroll
                for (int qt = 0; qt < 2; ++qt) s[qt] = __builtin_amdgcn_mfma_f32_32x32x16_bf16(ka, bq[qt][ks], s[qt], 0, 0, 0);
            }
            if (mixed) {
#pragma unroll
                for (int qt = 0; qt < 2; ++qt) {
                    const int qidx = qh * 64 + qt * 32 + l31;
#pragma unroll
                    for (int r = 0; r < 16; ++r) { const int kidx = sc * 32 + (r & 3) + 8 * (r >> 2) + 4 * hh; const bool ok = (c == 0) ? (kidx >= qidx) : (kidx <= qidx); if (!ok) s[qt][r] = -INFINITY; }
                }
            }
            bf16x8 pf[2][2];
#pragma unroll
            for (int qt = 0; qt < 2; ++qt) {
                float mx = s[qt][0];
#pragma unroll
                for (int r = 1; r < 16; ++r) mx = fmaxf(mx, s[qt][r]);
                mx = fmaxf(mx, __shfl_xor(mx, 32));
                const bool grow = mx > 0.f;
                if (__builtin_amdgcn_ballot_w64(grow) != 0ull) {
                    const float dlt = fmaxf(mx, 0.f), alpha = __builtin_amdgcn_exp2f(-dlt);
                    mrun[qt] += dlt; lrun[qt] *= alpha;
                    s[qt] = s[qt] - dlt;
#pragma unroll
                    for (int dt = 0; dt < 2; ++dt) oacc[dt][qt] = oacc[dt][qt] * alpha;
                }
                float p[16]; float ps = 0.f;
#pragma unroll
                for (int r = 0; r < 16; ++r) { p[r] = __builtin_amdgcn_exp2f(s[qt][r]); ps += p[r]; }
                lrun[qt] += ps;
#pragma unroll
                for (int ss = 0; ss < 2; ++ss) {
                    v4u pw; pw.x = pg8::cvt_pk_bf16(p[8 * ss + 0], p[8 * ss + 1]); pw.y = pg8::cvt_pk_bf16(p[8 * ss + 2], p[8 * ss + 3]); pw.z = pg8::cvt_pk_bf16(p[8 * ss + 4], p[8 * ss + 5]); pw.w = pg8::cvt_pk_bf16(p[8 * ss + 6], p[8 * ss + 7]);
                    pf[qt][ss] = __builtin_bit_cast(bf16x8, pw);
                }
            }
#pragma unroll
            for (int dt = 0; dt < 2; ++dt)
#pragma unroll
                for (int ss = 0; ss < 2; ++ss) {
                    const LAS bf16* vrow = Vt + (dt * 32 + dperm) * VP + sc * 32 + 16 * ss + 4 * hh;
                    const pg8::u32x2 vlo = *(const LAS pg8::u32x2*)vrow, vhi = *(const LAS pg8::u32x2*)(vrow + 8);
                    const bf16x8 vfrag = __builtin_bit_cast(bf16x8, (v4u){vlo.x, vlo.y, vhi.x, vhi.y});
#pragma unroll
                    for (int qt = 0; qt < 2; ++qt) oacc[dt][qt] = __builtin_amdgcn_mfma_f32_32x32x16_bf16(vfrag, pf[qt][ss], oacc[dt][qt], 0, 0, 0);
                }
        }
        c = cn;
    }
#pragma unroll
    for (int qt = 0; qt < 2; ++qt) {
        float l = lrun[qt]; l += __shfl_xor(l, 32);
        l += __builtin_amdgcn_exp2f(sk - mrun[qt]);
        const float inv = 1.0f / l;
        bf16* orow = O + (size_t)(q0 + qt * 32 + l31) * 1536 + hq * 64 + 8 * hh;
#pragma unroll
        for (int dt = 0; dt < 2; ++dt)
#pragma unroll
            for (int j2 = 0; j2 < 2; ++j2) {
                v4u w;
                w.x = pg8::cvt_pk_bf16(oacc[dt][qt][8 * j2 + 0] * inv, oacc[dt][qt][8 * j2 + 1] * inv); w.y = pg8::cvt_pk_bf16(oacc[dt][qt][8 * j2 + 2] * inv, oacc[dt][qt][8 * j2 + 3] * inv);
                w.z = pg8::cvt_pk_bf16(oacc[dt][qt][8 * j2 + 4] * inv, oacc[dt][qt][8 * j2 + 5] * inv); w.w = pg8::cvt_pk_bf16(oacc[dt][qt][8 * j2 + 6] * inv, oacc[dt][qt][8 * j2 + 7] * inv);
                *(v4u*)(orow + dt * 32 + 16 * j2) = w;
            }
    }
}
__device__ __forceinline__ void ffta_item(const Args& A, LAS unsigned char* lds, int item, int wave, int lane, int tid) {
    const bf16* F = (const bf16*)(A.ws + WS_F); bf16* Y1 = (bf16*)(A.ws + WS_Y1);
    const bf16* TA = (const bf16*)(A.ws + WS_TAB);
    const int b = item >> 7, s2 = item & 127, fr = lane & 15, fq = lane >> 4;
    constexpr int XP = 514;
    LAS bf16* X = (LAS bf16*)lds;
    __syncthreads();
    for (int i = tid; i < 64 * 64; i += 512) {
        const int s1 = i >> 6, pc = i & 63;
        const v4u v = *(const v4u*)(F + (size_t)(b * SEQ + 128 * s1 + s2) * 512 + pc * 8);
        LAS unsigned* d = (LAS unsigned*)(X + s1 * XP + pc * 8);
        d[0] = v.x; d[1] = v.y; d[2] = v.z; d[3] = v.w;
    }
    __syncthreads();
    bf16x8 af[4][2];
#pragma unroll
    for (int mt = 0; mt < 4; ++mt)
#pragma unroll
        for (int ks = 0; ks < 2; ++ks) {
            const LAS bf16* p = X + (32 * ks + 8 * fq) * XP + wave * 64 + mt * 16 + fr;
            bf16x8 av;
#pragma unroll
            for (int j = 0; j < 8; ++j) av[j] = (short)p[j * XP];
            af[mt][ks] = av;
        }
#pragma unroll 1
    for (int nh = 0; nh < 2; ++nh) {
        f32x4 acc[4][4];
#pragma unroll
        for (int nt = 0; nt < 4; ++nt) {
            const bf16x8 b0 = *(const bf16x8*)(TA + (size_t)((nh * 4 + nt) * 16 + fr) * 64 + fq * 8), b1 = *(const bf16x8*)(TA + (size_t)((nh * 4 + nt) * 16 + fr) * 64 + 32 + fq * 8);
#pragma unroll
            for (int mt = 0; mt < 4; ++mt) {
                f32x4 z = (f32x4){0.f, 0.f, 0.f, 0.f};
                z = __builtin_amdgcn_mfma_f32_16x16x32_bf16(af[mt][0], b0, z, 0, 0, 0);
                acc[mt][nt] = __builtin_amdgcn_mfma_f32_16x16x32_bf16(af[mt][1], b1, z, 0, 0, 0);
            }
        }
#pragma unroll
        for (int tt = 0; tt < 2; ++tt) {
            const int k1 = 16 * (2 * nh + tt) + fr;
            const float a = (float)((s2 * k1) & 8191) * (1.0f / 4096.0f);
            const float cth = cospif(a), sth = sinpif(a);
            bf16* dst = Y1 + ((size_t)((b * 64 + k1) * 128 + s2)) * 1024 + wave * 64 + 4 * fq;
#pragma unroll
            for (int mt = 0; mt < 4; ++mt) {
                const f32x4 yr = acc[mt][2 * tt], yi = acc[mt][2 * tt + 1];
                const f32x4 zr = yr * cth + yi * sth, zi = yi * cth - yr * sth;
                pg8::u32x2 w; w.x = pg8::cvt_pk_bf16(zr[0], zr[1]); w.y = pg8::cvt_pk_bf16(zr[2], zr[3]);
                *(pg8::u32x2*)(dst + mt * 16) = w;
                w.x = pg8::cvt_pk_bf16(zi[0], zi[1]); w.y = pg8::cvt_pk_bf16(zi[2], zi[3]);
                *(pg8::u32x2*)(dst + 512 + mt * 16) = w;
            }
        }
    }
}

typedef short s16x4 __attribute__((ext_vector_type(4)));
__device__ __forceinline__ void fftb_phase(const Args& A, LAS unsigned char* lds, int bx, int G, int wave, int lane, int tid) {
    const bf16* Y1 = (const bf16*)(A.ws + WS_Y1); bf16* P = (bf16*)(A.ws + WS_ACAT);
    const bf16* TB = (const bf16*)(A.ws + WS_TAB) + TA_ELEMS;
    const int fr = lane & 15, fq = lane >> 4, wm = wave >> 2, wn = wave & 3;
    constexpr int PB = 272, IMG = 256 * PB;
    bf16x8 bfr[8][4];
#pragma unroll
    for (int ks = 0; ks < 8; ++ks)
#pragma unroll
        for (int nt = 0; nt < 4; ++nt) bfr[ks][nt] = *(const bf16x8*)(TB + (size_t)((wn * 4 + nt) * 16 + fr) * 256 + ks * 32 + fq * 8);
    for (int it0 = bx; it0 < 512; it0 += 2 * G) {
        const int nimg = (it0 + G < 512) ? 2 : 1;
        __syncthreads();
        for (int img = 0; img < nimg; ++img) {
            const int it = it0 + img * G, g = it & 3, k1 = (it >> 2) & 63, b = it >> 8;
            const bf16* src = Y1 + ((size_t)((b * 64 + k1) * 128)) * 1024 + g * 128 + (tid & 15) * 8;
            LAS unsigned char* dstl = lds + img * IMG + (tid >> 4) * PB + (tid & 15) * 16;
#pragma unroll 1
            for (int jb = 0; jb < 2; ++jb) {
                v4u v[4];
#pragma unroll
                for (int jj = 0; jj < 4; ++jj) { const int K = (tid >> 4) + 32 * (4 * jb + jj), part = K >> 7, s2 = K & 127; v[jj] = *(const v4u*)(src + (size_t)s2 * 1024 + part * 512); }
#pragma unroll
                for (int jj = 0; jj < 4; ++jj) *(LAS v4u*)(dstl + 32 * (4 * jb + jj) * PB) = v[jj];
            }
        }
        __syncthreads();
        for (int img = 0; img < nimg; ++img) {
            const int it = it0 + img * G, g = it & 3, k1 = (it >> 2) & 63, b = it >> 8;
            f32x4 acc[4][4];
#pragma unroll
            for (int mt = 0; mt < 4; ++mt)
#pragma unroll
                for (int nt = 0; nt < 4; ++nt) acc[mt][nt] = (f32x4){0.f, 0.f, 0.f, 0.f};
            const LAS unsigned char* xb = lds + img * IMG + (8 * fq + (fr >> 2)) * PB + 16 * (fr & 3) + wm * 128;
#pragma unroll
            for (int ks = 0; ks < 8; ++ks) {
                bf16x8 af[4];
#pragma unroll
                for (int mt = 0; mt < 4; ++mt) {
                    const s16x4 lo = __builtin_amdgcn_ds_read_tr16_b64_v4i16((LAS s16x4*)(xb + (32 * ks) * PB + 64 * (mt >> 1) + 8 * (mt & 1)));
                    const s16x4 hi = __builtin_amdgcn_ds_read_tr16_b64_v4i16((LAS s16x4*)(xb + (32 * ks + 4) * PB + 64 * (mt >> 1) + 8 * (mt & 1)));
                    af[mt] = __builtin_shufflevector(lo, hi, 0, 1, 2, 3, 4, 5, 6, 7);
                }
#pragma unroll
                for (int mt = 0; mt < 4; ++mt)
#pragma unroll
                    for (int nt = 0; nt < 4; ++nt) acc[mt][nt] = __builtin_amdgcn_mfma_f32_16x16x32_bf16(af[mt], bfr[ks][nt], acc[mt][nt], 0, 0, 0);
            }
#pragma unroll
            for (int nt = 0; nt < 4; ++nt) {
                const int T = 4 * wn + nt, t = T >> 1, pp = T & 1, k2 = 16 * t + fr, sp = k1 + 64 * k2;
                bf16* dst = P + (size_t)(b * SEQ + sp) * 1536 + 512 + g * 256 + pp * 128 + wm * 64 + 8 * fq;
#pragma unroll
                for (int mp = 0; mp < 2; ++mp) {
                    const f32x4 z0 = acc[2 * mp][nt], z1 = acc[2 * mp + 1][nt];
                    v4u w; w.x = pg8::cvt_pk_bf16(z0[0], z0[1]); w.y = pg8::cvt_pk_bf16(z0[2], z0[3]); w.z = pg8::cvt_pk_bf16(z1[0], z1[1]); w.w = pg8::cvt_pk_bf16(z1[2], z1[3]);
                    *(v4u*)(dst + mp * 32) = w;
                }
            }
        }
    }
}

__global__ void __launch_bounds__(NWAVES * 64, 2) fwd_megakernel(Args A) {
    extern __shared__ __attribute__((aligned(16))) unsigned char lds_raw[];
    LAS unsigned char* lds = (LAS unsigned char*)lds_raw;
    volatile LAS unsigned* MISC = (volatile LAS unsigned*)(lds + MISC_OFF);
    const int tid = threadIdx.x;
#define FRESH() int tid_ = threadIdx.x; asm volatile("" : "+v"(tid_)); const int lane_ = tid_ & 63, wave_ = __builtin_amdgcn_readfirstlane(tid_ >> 6), gw_ = vcu * NWAVES + wave_
    const int G = gridDim.x, bx = blockIdx.x, vcu = (G % 8 == 0) ? (bx % 8) * (G / 8) + bx / 8 : bx;
    const int NGW = G * NWAVES;
    unsigned* ctl = (unsigned*)(A.ws + WS_CTL);
    for (int u = tid; u < (LDS_BYTES - LDSCTL_OFF) / 4; u += NWAVES * 64) ((LAS unsigned*)(lds + LDSCTL_OFF))[u] = 0u;
    __syncthreads();
    XcdBarrier bar = xcd_barrier_post(ctl + CW_BAR, MISC + 8);
    unsigned char* ws = A.ws;

    { FRESH(); p0a_adaln(A, gw_, NGW, lane_); }
    xcd_barrier(bar);
#ifdef PROBE_C2
    xcd_barrier(bar);
#endif
    { FRESH(); p0_setup(A, lds, gw_, NGW, vcu, G, wave_, lane_, tid_); p0b_win(A, lds, gw_, NGW, wave_, lane_); p1_norm(A, gw_, NGW, lane_); }
    xcd_barrier(bar);
    {
        pg8::Gemm g{(const pg8::bf16_t*)(ws + WS_H), (const pg8::bf16_t*)(ws + WS_WIN), MALL, INW, 1024, 64};
        pg8::OrderIn S; S.init(G, bx);
        pg8::EpiIn E{(pg8::bf16_t*)ws, QSCALE, ctl + CW_FCNT};
        pg8::gemm_phase<pg8::EpiIn, pg8::OrderIn, true, true>(lds, g, S, E);
#ifdef PROBE_G2
        __syncthreads(); pg8::gemm_phase<pg8::EpiIn, pg8::OrderIn, true, true>(lds, g, S, E);
#endif
    }
    {
        const int nu = 64 * 13 + 2, rounds = (nu + G - 1) / G, extra = nu - (rounds - 1) * G;
        FRESH();
        const int part0 = (extra >= G) ? 0 : extra, nbp = G - part0;
        if (bx >= part0) {
            p0_deferred(A, lds, (bx - part0) * NWAVES + wave_, nbp * NWAVES, bx - part0, nbp, wave_, lane_, tid_);
            if (tid_ == 0) {
                unsigned spins = 0;
                while (__hip_atomic_load(ctl + CW_FCNT, __ATOMIC_RELAXED, __HIP_MEMORY_SCOPE_AGENT) < 128u * 8u) { __builtin_amdgcn_s_sleep(4); if (++spins > (1u << 20)) break; }
                __builtin_amdgcn_fence(__ATOMIC_ACQUIRE, "agent");
                asm volatile("s_waitcnt vmcnt(0)" ::: "memory");
            }
            __syncthreads();
            for (int it = bx - part0; it < 256; it += nbp) ffta_item(A, lds, it, wave_, lane_, tid_);
        }
    }
    xcd_barrier(bar);
#ifdef PROBE_C2
    xcd_barrier(bar);
#endif
    { FRESH(); for (int u = vcu; u < 256; u += G) attn_unit(A, lds, u, wave_, lane_, tid_); }
    { FRESH(); fftb_phase(A, lds, vcu, G, wave_, lane_, tid_); }
    xcd_barrier(bar);
    {
        pg8::Gemm g{(const pg8::bf16_t*)(ws + WS_ACAT), (const pg8::bf16_t*)(ws + WS_WCAT), MTOK, 1024, 1536, 64};
        pg8::StaticOrder S; S.init(MTOK, 1024, G, bx);
        pg8::EpiMerge E{(const pg8::bf16_t*)(ws + WS_GA), (const pg8::bf16_t*)(ws + WS_GF), (pg8::bf16_t*)(ws + WS_MB)};
        pg8::gemm_phase<pg8::EpiMerge, pg8::StaticOrder, true, true>(lds, g, S, E);
#ifdef PROBE_G5
        __syncthreads(); pg8::gemm_phase<pg8::EpiMerge, pg8::StaticOrder, true, true>(lds, g, S, E);
#endif
    }
    xcd_barrier(bar);
    {
        float* ctlf = (float*)(ws + WS_CTL);
        pg8::Gemm g{(const pg8::bf16_t*)(ws + WS_MB), (const pg8::bf16_t*)(ws + WS_WOUT), MTOK, 1024, 1024, 64};
        pg8::StaticOrder S; S.init(MTOK, 1024, G, bx);
        EpiOutNorm E{A.x, (pg8::bf16_t*)(ws + WS_YB), (pg8::bf16_t*)(ws + WS_H), ctlf + CW_MOD, A.g_post1, A.g_pre2, ctlf + CW_RS1, ctlf + CW_RS2, ctl + CW_PCNT};
        pg8::gemm_phase<EpiOutNorm, pg8::StaticOrder, false, true>(lds, g, S, E);
    }
    xcd_barrier(bar);
    {
        pg8::Gemm g{(const pg8::bf16_t*)(ws + WS_H), (const pg8::bf16_t*)(ws + WS_WUP), 67 * 256, 2 * DFF, 1024, 62};
        pg8::StaticOrder S; S.init(67 * 256, 2 * DFF, G, bx);
        pg8::EpiUp E{A.conv_w, A.conv_b, (pg8::bf16_t*)(ws + WS_G)};
        pg8::gemm_phase<pg8::EpiUp, pg8::StaticOrder, true, true>(lds, g, S, E);
#ifdef PROBE_G8
        __syncthreads(); pg8::gemm_phase<pg8::EpiUp, pg8::StaticOrder, true, true>(lds, g, S, E);
#endif
    }
    xcd_barrier(bar);
    {
        float* ctlf = (float*)(ws + WS_CTL);
        pg8::Gemm g{(const pg8::bf16_t*)(ws + WS_G), (const pg8::bf16_t*)(ws + WS_WDN), MTOK, 1024, DFF, 64};
        pg8::StaticOrder S; S.init(MTOK, 1024, G, bx);
        EpiDownNorm E{(const pg8::bf16_t*)(ws + WS_YB), A.out, ctlf + CW_MOD, A.g_post2, ctlf + CW_RS3, ctl + CW_PCNT + 128};
        pg8::gemm_phase<EpiDownNorm, pg8::StaticOrder, false, true>(lds, g, S, E);
    }
}

extern "C" void kernel_launch(void* const* d_in, const int* in_sizes, int n_in, void* d_out, int out_size, void* d_ws, size_t ws_size, hipStream_t stream) {
    static int grid = 0;
    if (grid == 0) {
        if (n_in != 19 || ws_size < WS_END) { fprintf(stderr, "kernel_launch: unexpected inputs (n_in %d, ws %zu)\n", n_in, ws_size); grid = -1; return; }
        int dev = 0, cus = 0, per_cu = 0;
        if (hipGetDevice(&dev) != hipSuccess || hipDeviceGetAttribute(&cus, hipDeviceAttributeMultiprocessorCount, dev) != hipSuccess) { grid = -1; return; }
        if (hipFuncSetAttribute((const void*)fwd_megakernel, hipFuncAttributeMaxDynamicSharedMemorySize, LDS_BYTES) != hipSuccess) { fprintf(stderr, "kernel_launch: hipFuncSetAttribute failed\n"); grid = -1; return; }
        if (hipOccupancyMaxActiveBlocksPerMultiprocessor(&per_cu, (const void*)fwd_megakernel, NWAVES * 64, LDS_BYTES) != hipSuccess || per_cu < 1) { fprintf(stderr, "kernel_launch: occupancy query reports %d\n", per_cu); }
        (void)hipGetLastError();
        grid = cus;
    }
    if (grid < 0) return;
    if (hipMemsetAsync((char*)d_ws + WS_CTL, 0, CTL_ZERO_BYTES, stream) != hipSuccess) return;
    Args a{};
    const float** ap = (const float**)&a;
    for (int i = 0; i < 19; ++i) ap[i] = (const float*)d_in[i];
    a.out = (float*)d_out; a.ws = (unsigned char*)d_ws;
    hipLaunchKernelGGL(fwd_megakernel, dim3(grid), dim3(NWAVES * 64), LDS_BYTES, stream, a);
}
```
